# Optimizing an MI355X kernel written in HIP

```python
import math
import jax
import jax.numpy as jnp
from jax import lax
import numpy as np

D_MODEL = 1024
BATCH = 8
SEQ = 2048
DEPTH = 1
DEC_BATCH = 128
DEC_SEQ = 4
PAST_LEN = 16384
PAGE_SIZE = 128

HG_HEADS = 4
HG_DK = 128
HG_DV = 128
HG_WIDTH = HG_HEADS * HG_DK
GDN_HEADS = 4
GDN_DK = 128
GDN_DV = 128
GDN_QK = GDN_HEADS * GDN_DK
GDN_V = GDN_HEADS * GDN_DV
CONV_W = 4
CONV_CH = 2 * GDN_QK + GDN_V
MEM_LEN = 256
MEM_HEADS = 4
MEM_HD = 128
MEM_WIDTH = MEM_HEADS * MEM_HD
N_BRANCH = 3
FF_RAW = -(-8 * D_MODEL // 3)
FFN_HIDDEN = -(-FF_RAW // 256) * 256
IN_WIDTH = 4 * HG_WIDTH + CONV_CH + GDN_V + 2 * GDN_HEADS + MEM_WIDTH + N_BRANCH * D_MODEL
CHUNK = 64
EPS = 1e-6

kernel_name = "hgrn2_gdn_memxattn_gated_parallel_decoder_step"

F32 = jnp.float32


def rmsnorm(x, g):
    xf = x.astype(F32)
    y = xf * lax.rsqrt(jnp.mean(xf * xf, axis=-1, keepdims=True) + EPS)
    return (y * g.astype(F32)).astype(x.dtype)


def l2norm(x):
    xf = x.astype(F32)
    return xf * lax.rsqrt(jnp.sum(xf * xf, axis=-1, keepdims=True) + EPS)


def _chunk_dims(T):
    c = min(CHUNK, T)
    return c, -(-T // c)


def _to_chunks(a, c, n):
    B, T = a.shape[0], a.shape[1]
    a = jnp.pad(a, [(0, 0), (0, n * c - T)] + [(0, 0)] * (a.ndim - 2))
    a = a.reshape((B, n, c) + a.shape[2:])
    return jnp.moveaxis(jnp.moveaxis(a, 1, 0), 2, 3)


def _from_chunks(o, T):
    n, B, H, c, d = o.shape
    return o.transpose(1, 0, 3, 2, 4).reshape(B, n * c, H, d)[:, :T]


def hgrn2_chunked(q, k, v, logf, s0):
    T = q.shape[1]
    c, n = _chunk_dims(T)
    tri = jnp.tril(jnp.ones((c, c), bool))

    def step(S, inp):
        qc, kc, vc, lc = inp
        G = jnp.cumsum(lc, axis=2)
        diff = G[:, :, :, None, :] - G[:, :, None, :, :]
        dec = jnp.exp(jnp.where(tri[:, :, None], diff, -jnp.inf))
        A = jnp.einsum('bhtd,bhsd,bhtsd->bhts', qc, kc, dec)
        o = (jnp.einsum('bhts,bhsv->bhtv', A, vc)
             + jnp.einsum('bhtd,bhdv->bhtv', qc * jnp.exp(G), S))
        GC = G[:, :, -1:]
        S = (jnp.exp(GC[:, :, 0])[..., None] * S
             + jnp.einsum('bhsd,bhsv->bhdv', kc * jnp.exp(GC - G), vc))
        return S, o

    xs = tuple(_to_chunks(a.astype(F32), c, n) for a in (q, k, v, logf))
    S, o = lax.scan(step, s0.astype(F32), xs)
    return _from_chunks(o, T), S


def gdn_chunked(q, k, v, beta, g, s0):
    T = q.shape[1]
    c, n = _chunk_dims(T)
    tri = jnp.tril(jnp.ones((c, c), bool))
    strict = jnp.tril(jnp.ones((c, c), bool), k=-1)
    eye = jnp.eye(c, dtype=F32)

    def step(S, inp):
        qc, kc, vc, bc, gc = inp
        G = jnp.cumsum(gc, axis=-1)
        L = jnp.exp(jnp.where(tri, G[..., :, None] - G[..., None, :], -jnp.inf))
        kb = kc * bc[..., None]
        M = jnp.where(strict, jnp.einsum('bhtd,bhsd->bhts', kb, kc) * L, 0.0)
        rhs = jnp.concatenate([vc * bc[..., None], kb * jnp.exp(G)[..., None]], axis=-1)
        X = lax.linalg.triangular_solve(eye + M, rhs, left_side=True, lower=True,
                                        unit_diagonal=True)
        u, w = X[..., :GDN_DV], X[..., GDN_DV:]
        v_new = u - jnp.einsum('bhtd,bhdv->bhtv', w, S)
        Aqk = jnp.where(tri, jnp.einsum('bhtd,bhsd->bhts', qc, kc) * L, 0.0)
        o = (jnp.einsum('bhtd,bhdv->bhtv', qc * jnp.exp(G)[..., None], S)
             + jnp.einsum('bhts,bhsv->bhtv', Aqk, v_new))
        GC = G[..., -1:]
        S = (jnp.exp(GC)[..., None] * S
             + jnp.einsum('bhsd,bhsv->bhdv', kc * jnp.exp(GC - G)[..., None], v_new))
        return S, o

    xs = (_to_chunks(q.astype(F32), c, n), _to_chunks(k.astype(F32), c, n),
          _to_chunks(v.astype(F32), c, n), _to_chunks(beta.astype(F32), c, n),
          _to_chunks(g.astype(F32), c, n))
    S, o = lax.scan(step, s0.astype(F32), xs)
    return _from_chunks(o, T), S


def causal_conv(u, buf, w):
    T = u.shape[1]
    up = jnp.concatenate([buf.astype(u.dtype), u], axis=1)
    out = up[:, 0:T] * w[0]
    for j in range(1, CONV_W):
        out = out + up[:, j:j + T] * w[j]
    return out, up[:, -(CONV_W - 1):]


def _split_in(proj):
    sizes = [HG_WIDTH] * 4 + [CONV_CH, GDN_V, GDN_HEADS, GDN_HEADS, MEM_WIDTH, N_BRANCH * D_MODEL]
    points = []
    acc = 0
    for s in sizes[:-1]:
        acc += s
        points.append(acc)
    return jnp.split(proj, points, axis=-1)


def _mem_kv(mem, g_mem, w_mem_kv):
    B, M = mem.shape[0], mem.shape[1]
    kv = rmsnorm(mem, g_mem) @ w_mem_kv
    k, v = jnp.split(kv, 2, axis=-1)
    return k.reshape(B, M, MEM_HEADS, MEM_HD), v.reshape(B, M, MEM_HEADS, MEM_HD)


def _layer(x, mem_k, mem_v, conv_buf, s_hg, s_gdn, lb,
           g_pre_mix, w_in, w_conv, a_log, dt_bias, g_hg_out, g_gdn_out,
           w_br_hg, w_br_gdn, w_br_mem, w_out, g_post_mix, g_pre_ffn,
           w_ffn_in, w_ffn_out, g_post_ffn):
    B, T, _ = x.shape
    dt = x.dtype
    xn = rmsnorm(x, g_pre_mix)
    (hg_q, hg_f, hg_i, hg_gate, gdn_qkv, gdn_z, gdn_a, gdn_b,
     mem_q, gates) = _split_in(xn @ w_in)

    f = lb + (1.0 - lb) * jax.nn.sigmoid(hg_f.astype(F32))
    logf = jnp.log(f)
    hk = 1.0 - f
    o_hg, s_hg_new = hgrn2_chunked(hg_q.reshape(B, T, HG_HEADS, HG_DK),
                                   hk.reshape(B, T, HG_HEADS, HG_DK),
                                   hg_i.reshape(B, T, HG_HEADS, HG_DV),
                                   logf.reshape(B, T, HG_HEADS, HG_DK), s_hg)
    o_hg = (rmsnorm(o_hg, g_hg_out.reshape(HG_HEADS, HG_DV))
            * jax.nn.silu(hg_gate.astype(F32)).reshape(B, T, HG_HEADS, HG_DV))
    o_hg = o_hg.reshape(B, T, HG_WIDTH).astype(dt)

    qkv, conv_new = causal_conv(gdn_qkv, conv_buf, w_conv)
    qkv = jax.nn.silu(qkv)
    gq, gk, gv = jnp.split(qkv, [GDN_QK, 2 * GDN_QK], axis=-1)
    gq = l2norm(gq.reshape(B, T, GDN_HEADS, GDN_DK)) * (GDN_DK ** -0.5)
    gk = l2norm(gk.reshape(B, T, GDN_HEADS, GDN_DK))
    gv = gv.reshape(B, T, GDN_HEADS, GDN_DV)
    beta = jax.nn.sigmoid(gdn_b.astype(F32))
    glog = -jnp.exp(a_log.astype(F32)) * jax.nn.softplus(gdn_a.astype(F32) + dt_bias.astype(F32))
    o_gdn, s_gdn_new = gdn_chunked(gq, gk, gv, beta, glog, s_gdn)
    o_gdn = (rmsnorm(o_gdn, g_gdn_out)
             * jax.nn.silu(gdn_z.astype(F32)).reshape(B, T, GDN_HEADS, GDN_DV))
    o_gdn = o_gdn.reshape(B, T, GDN_V).astype(dt)

    mq = mem_q.reshape(B, T, MEM_HEADS, MEM_HD).astype(F32)
    s = jnp.einsum('bthd,bmhd->bhtm', mq, mem_k.astype(F32)) * (MEM_HD ** -0.5)
    p = jax.nn.softmax(s, axis=-1)
    o_mem = jnp.einsum('bhtm,bmhd->bthd', p, mem_v.astype(F32)).reshape(B, T, MEM_WIDTH).astype(dt)

    g_hg, g_gdn, g_mem = jnp.split(jax.nn.sigmoid(gates), N_BRANCH, axis=-1)
    merged = g_hg * (o_hg @ w_br_hg) + g_gdn * (o_gdn @ w_br_gdn) + g_mem * (o_mem @ w_br_mem)
    h = x + rmsnorm(merged @ w_out, g_post_mix)

    gate, up = jnp.split(rmsnorm(h, g_pre_ffn) @ w_ffn_in, 2, axis=-1)
    ff = (jax.nn.silu(gate) * up) @ w_ffn_out
    y = h + rmsnorm(ff, g_post_ffn)
    return y.astype(dt), conv_new.astype(dt), s_hg_new.astype(dt), s_gdn_new.astype(dt)


def setup_inputs(seed: int = 0) -> dict:
    key = jax.random.key(seed)
    ks = iter(jax.random.split(key, 32))

    def nrm(shape, scale):
        return jax.random.normal(next(ks), shape, F32) * scale

    def gain(shape):
        return 1.0 + nrm(shape, 0.05)

    a_log = jnp.log(jax.random.uniform(next(ks), (DEPTH, GDN_HEADS), F32, 1.0, 16.0))
    dtv = jnp.exp(jax.random.uniform(next(ks), (DEPTH, GDN_HEADS), F32,
                                     math.log(1e-3), math.log(1e-1)))
    dt_bias = dtv + jnp.log(-jnp.expm1(-dtv))
    return {
        "x_prompt": nrm((BATCH, SEQ, D_MODEL), 1.0),
        "x_sample": nrm((DEC_BATCH, DEC_SEQ, D_MODEL), 1.0),
        "mem_prompt": nrm((BATCH, MEM_LEN, D_MODEL), 1.0),
        "cache_mem_k": nrm((DEPTH, DEC_BATCH, MEM_LEN, MEM_HEADS, MEM_HD), 1.0),
        "cache_mem_v": nrm((DEPTH, DEC_BATCH, MEM_LEN, MEM_HEADS, MEM_HD), 1.0),
        "state_hgrn": nrm((DEPTH, DEC_BATCH, HG_HEADS, HG_DK, HG_DV), 0.5),
        "state_gdn": nrm((DEPTH, DEC_BATCH, GDN_HEADS, GDN_DK, GDN_DV), 0.1),
        "state_gdn_conv": nrm((DEPTH, DEC_BATCH, CONV_W - 1, CONV_CH), 1.0),
        "hg_lb_logits": nrm((DEPTH + 1, HG_WIDTH), 0.5),
        "g_pre_mix": gain((DEPTH, D_MODEL)),
        "w_in": nrm((DEPTH, D_MODEL, IN_WIDTH), D_MODEL ** -0.5),
        "w_conv": nrm((DEPTH, CONV_W, CONV_CH), 0.5),
        "a_log": a_log,
        "dt_bias": dt_bias,
        "g_hg_out": gain((DEPTH, HG_WIDTH)),
        "g_gdn_out": gain((DEPTH, GDN_DV)),
        "g_mem": gain((DEPTH, D_MODEL)),
        "w_mem_kv": nrm((DEPTH, D_MODEL, 2 * MEM_WIDTH), D_MODEL ** -0.5),
        "w_br_hg": nrm((DEPTH, HG_WIDTH, D_MODEL), HG_WIDTH ** -0.5),
        "w_br_gdn": nrm((DEPTH, GDN_V, D_MODEL), GDN_V ** -0.5),
        "w_br_mem": nrm((DEPTH, MEM_WIDTH, D_MODEL), MEM_WIDTH ** -0.5),
        "w_out": nrm((DEPTH, D_MODEL, D_MODEL), D_MODEL ** -0.5),
        "g_post_mix": gain((DEPTH, D_MODEL)),
        "g_pre_ffn": gain((DEPTH, D_MODEL)),
        "w_ffn_in": nrm((DEPTH, D_MODEL, 2 * FFN_HIDDEN), D_MODEL ** -0.5),
        "w_ffn_out": nrm((DEPTH, FFN_HIDDEN, D_MODEL), FFN_HIDDEN ** -0.5),
        "g_post_ffn": gain((DEPTH, D_MODEL)),
    }


def reference(x_prompt, x_sample, mem_prompt, cache_mem_k, cache_mem_v, state_hgrn,
              state_gdn, state_gdn_conv, hg_lb_logits, g_pre_mix, w_in, w_conv, a_log,
              dt_bias, g_hg_out, g_gdn_out, g_mem, w_mem_kv, w_br_hg, w_br_gdn, w_br_mem,
              w_out, g_post_mix, g_pre_ffn, w_ffn_in, w_ffn_out, g_post_ffn):
    lb_all = jnp.cumsum(jax.nn.softmax(hg_lb_logits.astype(F32), axis=0), axis=0)
    yp, ys = x_prompt, x_sample
    Bp = x_prompt.shape[0]
    mk_p, mv_p, hg_p, gdn_p, conv_p = [], [], [], [], []
    hg_s, gdn_s, conv_s = [], [], []
    for l in range(DEPTH):
        lw = (g_pre_mix[l], w_in[l], w_conv[l], a_log[l], dt_bias[l], g_hg_out[l],
              g_gdn_out[l], w_br_hg[l], w_br_gdn[l], w_br_mem[l], w_out[l], g_post_mix[l],
              g_pre_ffn[l], w_ffn_in[l], w_ffn_out[l], g_post_ffn[l])
        mk, mv = _mem_kv(mem_prompt, g_mem[l], w_mem_kv[l])
        conv0 = jnp.zeros((Bp, CONV_W - 1, CONV_CH), x_prompt.dtype)
        hg0 = jnp.zeros((Bp, HG_HEADS, HG_DK, HG_DV), F32)
        gdn0 = jnp.zeros((Bp, GDN_HEADS, GDN_DK, GDN_DV), F32)
        yp, cb, sh, sg = _layer(yp, mk, mv, conv0, hg0, gdn0, lb_all[l], *lw)
        mk_p.append(mk.astype(x_prompt.dtype))
        mv_p.append(mv.astype(x_prompt.dtype))
        hg_p.append(sh)
        gdn_p.append(sg)
        conv_p.append(cb)
        ys, cb2, sh2, sg2 = _layer(ys, cache_mem_k[l], cache_mem_v[l], state_gdn_conv[l],
                                   state_hgrn[l], state_gdn[l], lb_all[l], *lw)
        hg_s.append(sh2)
        gdn_s.append(sg2)
        conv_s.append(cb2)
    return (yp, ys, jnp.stack(mk_p), jnp.stack(mv_p), jnp.stack(hg_p), jnp.stack(gdn_p),
            jnp.stack(conv_p), jnp.stack(hg_s), jnp.stack(gdn_s), jnp.stack(conv_s))
```

```cpp
#include <hip/hip_runtime.h>
#include <hip/hip_cooperative_groups.h>
#include <cstdio>
#include <cstdint>
namespace cg = cooperative_groups;

#define LAS __attribute__((address_space(3)))
typedef unsigned short bf16_t;
typedef short bf16x8 __attribute__((ext_vector_type(8)));
typedef short bf16x4 __attribute__((ext_vector_type(4)));
typedef float f32x4 __attribute__((ext_vector_type(4)));
typedef float f32x2 __attribute__((ext_vector_type(2)));
typedef unsigned u32x4 __attribute__((ext_vector_type(4)));
typedef unsigned u32x2 __attribute__((ext_vector_type(2)));

constexpr int DM = 1024, MP = 16384, MS = 512, MT = MP + MS, TSEQ = 2048, NB = 8, NBS = 128;
constexpr int NPROJ = 7680, FFH = 2816, INW = 7688;
constexpr int C_HQ = 0, C_HF = 512, C_HI = 1024, C_HG = 1536, C_GQKV = 2048, C_GZ = 3584, C_MQ = 4096, C_GATE = 4608;
constexpr float EPSF = 1e-6f;
constexpr int LDS_BYTES = 147456;
#ifndef PROBE_DRY
#define PROBE_DRY 0
#endif
#ifndef PROBE_MASK
#define PROBE_MASK 0
#endif

constexpr size_t al256(size_t x) { return (x + 255) & ~(size_t)255; }
constexpr size_t WS_WIN = 0;
constexpr size_t WS_WKV = WS_WIN + (size_t)NPROJ * DM * 2;
constexpr size_t WS_WBR = WS_WKV + (size_t)DM * DM * 2;
constexpr size_t WS_WOUT = WS_WBR + (size_t)3 * DM * 512 * 2;
constexpr size_t WS_RX = WS_WOUT + (size_t)DM * DM * 2;
constexpr size_t WS_RMEM = WS_RX + al256((size_t)MT * 4);
constexpr size_t WS_AB = WS_RMEM + al256(2048 * 4);
constexpr size_t WS_DEC = WS_AB + al256((size_t)MT * 8 * 4);
constexpr size_t WS_GCS = WS_DEC + (size_t)1024 * 128 * 4;
constexpr size_t WS_PSS = WS_GCS + al256(1024 * 4);
constexpr size_t WS_RH = WS_PSS + (size_t)MT * 16 * 4;
constexpr size_t WS_MEMB = WS_RH + al256((size_t)MT * 4);
constexpr size_t WS_MEMK = WS_MEMB + (size_t)2048 * 1024 * 2;
constexpr size_t WS_MEMV = WS_MEMK + (size_t)2048 * 512 * 2;
constexpr size_t WS_PROJ = WS_MEMV + (size_t)2048 * 512 * 2;
constexpr size_t WS_G2 = WS_PROJ + (size_t)MT * NPROJ * 2;
constexpr size_t WS_KGT = WS_G2, WS_QG = WS_G2 + 16777216, WS_AQK = WS_G2 + 2 * 16777216;
constexpr size_t WS_MERGED = WS_G2;
constexpr size_t WS_BAR = WS_G2 + 41943040;
constexpr size_t WS_WF1 = WS_BAR + 16384;
constexpr size_t WS_WF2 = WS_WF1 + (size_t)2 * FFH * DM * 2;
constexpr size_t WS_MRGS = WS_WF2 + (size_t)DM * FFH * 2;
constexpr size_t WS_END = WS_MRGS + (size_t)MS * DM * 2;
constexpr size_t WS_HB = WS_PROJ;
constexpr size_t WS_ACT = WS_HB + (size_t)MT * DM * 2;
constexpr size_t WS_FF = WS_ACT + (size_t)MT * FFH * 2;
constexpr size_t WS_PART = WS_FF + (size_t)MT * DM * 4;
static_assert(WS_PART + (size_t)11 * MS * DM * 4 <= WS_G2, "late buffers overflow proj area");
static_assert(WS_END <= 362000000, "workspace too large");
constexpr size_t O_Y = 0, O_MK = 17301504, O_MV = 18350080, O_HGP = 19398656, O_GDP = 19922944, O_CVP = 20447232,
                 O_HGS = 20484096, O_GDS = 28872704, O_CVS = 37261312;
constexpr size_t OB_DS = 0, OB_UT = 33554432, OB_W = OB_UT + 16777216;
constexpr size_t OB_XB = O_HGS * 4;

struct Args {
    const float* in[27];
    float* out;
    unsigned char* ws;
    int ph_lo, ph_hi;
};
typedef const Args __attribute__((address_space(4)))* KA;
__device__ __forceinline__ int otid() { int t = threadIdx.x; asm volatile("" : "+v"(t)); return t; }
__device__ __forceinline__ int obid() { int t = blockIdx.x; asm volatile("" : "+s"(t)); return t; }
__device__ __forceinline__ KA kargs() { KA p = (KA)__builtin_amdgcn_kernarg_segment_ptr(); asm volatile("" : "+s"(p)); return p; }

__device__ __forceinline__ float bf2f(bf16_t b) { return __uint_as_float(((unsigned)b) << 16); }
__device__ __forceinline__ bf16_t f2bf(float f) { unsigned u = __float_as_uint(f); u += 0x7FFFu + ((u >> 16) & 1u); return (bf16_t)(u >> 16); }
__device__ __forceinline__ unsigned pk2(float lo, float hi) { return (unsigned)f2bf(lo) | ((unsigned)f2bf(hi) << 16); }
template <int CTRL> __device__ __forceinline__ float dppf(float v) { return __int_as_float(__builtin_amdgcn_update_dpp(0, __float_as_int(v), CTRL, 0xf, 0xf, true)); }
__device__ __forceinline__ float wave_sum(float v) {
    v += dppf<0xB1>(v);
    v += dppf<0x4E>(v);
    v += dppf<0x141>(v);
    v += dppf<0x140>(v);
    const int vi = __float_as_int(v);
    return (__int_as_float(__builtin_amdgcn_readlane(vi, 0)) + __int_as_float(__builtin_amdgcn_readlane(vi, 16))) + (__int_as_float(__builtin_amdgcn_readlane(vi, 32)) + __int_as_float(__builtin_amdgcn_readlane(vi, 48)));
}
__device__ __forceinline__ float sigmoidf_(float x) { return __builtin_amdgcn_rcpf(1.0f + __expf(-x)); }
__device__ __forceinline__ float siluf_(float x) { return x * __builtin_amdgcn_rcpf(1.0f + __expf(-x)); }
__device__ __forceinline__ f32x4 mfma16(bf16x8 a, bf16x8 b, f32x4 c) { return __builtin_amdgcn_mfma_f32_16x16x32_bf16(a, b, c, 0, 0, 0); }


#define XB_TMO      128
#define XB_XCNT(j)  (256  + 64 * (j))
#define XB_XSUB(j)  (1280 + 64 * (j))
#define XB_XGEN(j)  (2304 + 64 * (j))
#define XB_TOP      3328
#define XB_TOPGEN   3392
#define XCD_BAR_WORDS 3456
#define XB_SPIN_CAP (1u << 18)
__device__ __forceinline__ unsigned xb_ld(unsigned* p)              { return __hip_atomic_load(p, __ATOMIC_RELAXED, __HIP_MEMORY_SCOPE_AGENT); }
__device__ __forceinline__ unsigned xb_add(unsigned* p, unsigned v) { return __hip_atomic_fetch_add(p, v, __ATOMIC_RELAXED, __HIP_MEMORY_SCOPE_AGENT); }
__device__ __forceinline__ unsigned xb_xcc_id() { return (unsigned)__builtin_amdgcn_s_getreg((3 << 11) | 20) & 0xFu; }
#define XB_SPIN(cond, bar) do { unsigned _sp = 0; while (cond) { __builtin_amdgcn_s_sleep(1); \
    if ((++_sp & 255u) == 0u) { if (xb_ld(&(bar)[XB_TMO])) break; if (_sp > XB_SPIN_CAP) { atomicAdd(&(bar)[XB_TMO], 1u); break; } } } } while (0)
struct XcdBarrier { unsigned* bar; unsigned x; volatile LAS unsigned* st; };
__device__ __forceinline__ XcdBarrier xcd_barrier_post(unsigned* bar, volatile LAS unsigned* st) {
    XcdBarrier b; b.bar = bar; b.x = xb_xcc_id(); b.st = st;
    if (threadIdx.x == 0) (void)xb_add(&bar[XB_XCNT(b.x)], 1u);
    return b;
}
__device__ __forceinline__ void xcd_barrier_complete(unsigned* bar, unsigned x, unsigned& nloc, unsigned& nx) {
    const unsigned G = gridDim.x * gridDim.y * gridDim.z;
    unsigned sum, cnt, mine, sp = 0u;
    for (;;) {
        sum = 0u; cnt = 0u; mine = 0u;
#pragma unroll
        for (unsigned j = 0; j < 16; ++j) { const unsigned c = xb_ld(&bar[XB_XCNT(j)]); sum += c; cnt += (c > 0u) ? 1u : 0u; mine = (j == x) ? c : mine; }
        if (sum == G) break;
        __builtin_amdgcn_s_sleep(1);
        if ((++sp & 255u) == 0u) { if (xb_ld(&bar[XB_TMO])) break; if (sp > XB_SPIN_CAP) { atomicAdd(&bar[XB_TMO], 1u); break; } }
    }
    nloc = mine > 0u ? mine : 1u; nx = cnt > 0u ? cnt : 1u;
}
__device__ __forceinline__ void xcd_barrier(const XcdBarrier& b) {
    asm volatile("s_waitcnt vmcnt(0)" ::: "memory");
    __syncthreads();
    if (threadIdx.x == 0) {
        unsigned* bar = b.bar;
        __builtin_amdgcn_s_waitcnt(0);
        unsigned nloc = b.st[0], nx = b.st[1];
        if (nloc == 0u) { xcd_barrier_complete(bar, b.x, nloc, nx); b.st[0] = nloc; b.st[1] = nx; }
        const unsigned old = xb_add(&bar[XB_XSUB(b.x)], 1u);
        const unsigned gen = old / nloc;
        if (old + 1u == (gen + 1u) * nloc) {
            __builtin_amdgcn_fence(__ATOMIC_RELEASE, "agent");
            asm volatile("s_waitcnt vmcnt(0)" ::: "memory");
            const unsigned og = xb_add(&bar[XB_TOP], 1u);
            const unsigned tg = og / nx;
            if (og + 1u == (tg + 1u) * nx) xb_add(&bar[XB_TOPGEN], 1u);
            else XB_SPIN(xb_ld(&bar[XB_TOPGEN]) == tg, bar);
            __builtin_amdgcn_fence(__ATOMIC_ACQUIRE, "agent");
            xb_add(&bar[XB_XGEN(b.x)], 1u);
            asm volatile("s_waitcnt vmcnt(0)" ::: "memory");
        } else {
            XB_SPIN(xb_ld(&bar[XB_XGEN(b.x)]) == gen, bar);
            __builtin_amdgcn_fence(__ATOMIC_ACQUIRE, "agent");
            asm volatile("s_waitcnt vmcnt(0)" ::: "memory");
        }
    }
    __syncthreads();
}

namespace pg8 {
constexpr int BM = 256, BK = 64, HALF = 128, HTB = HALF * BK * 2, STAGE_BYTES = 8 * HTB, NXCD = 8, WGM = 8;
__host__ __device__ __forceinline__ int lds_byte(int r, int c) { const int st = (r >> 4) * 2 + (c >> 5), rr = r & 15, cc = c & 31, ob = rr * 64 + cc * 2; return st * 1024 + (ob ^ (((ob >> 9) & 1) << 5)); }
__host__ __device__ __forceinline__ void stage_rc(int b, int& R, int& C) { const int st = b / 1024, sb = b % 1024, swz = sb ^ (((sb >> 9) & 1) << 5); R = (st >> 1) * 16 + swz / 64; C = (st & 1) * 32 + (swz % 64) / 2; }
__host__ __device__ __forceinline__ int perm32(int rho) { const int n = rho >> 4, i = rho & 15; return 8 * (i >> 2) + 4 * n + (i & 3); }
struct Unit { int pm, pn, koff, nt, tag; };
struct Gemm { const bf16_t* A; const bf16_t* Bt; int M, N, K, lda; const bf16_t* A2; };
struct StaticOrder {
    int nM, nN, nwg, G, c;
    __device__ void init(int M, int N, int G_, int c_, int K = 1024) { nM = M / BM; nN = N / BM; nwg = nM * nN; G = G_; c = c_; ntk = K / BK; }
    __device__ bool next(int i, Unit& u) const {
        const long L = (long)i * G + c; if (L >= nwg) return false;
        int wgid = (int)L; { const int q = nwg / NXCD, r = nwg % NXCD, xcd = wgid % NXCD, off = wgid / NXCD; wgid = (xcd < r ? xcd * (q + 1) : r * (q + 1) + (xcd - r) * q) + off; }
        const int nig = WGM * nN, gid = wgid / nig, fm = gid * WGM, gsz = (nM - fm) < WGM ? (nM - fm) : WGM;
        u.pm = fm + ((wgid % nig) % gsz); u.pn = (wgid % nig) / gsz; u.koff = 0; u.nt = ntk; u.tag = 0; return true;
    }
    int ntk;
};
struct TailOrder {
    StaticOrder base; int nsplit, njobs;
    __device__ void init(int N, int K, int G_, int c_, int nsplit_) { base.init(MP, N, G_, c_, K); nsplit = nsplit_; njobs = 8 * nsplit_; }
    __device__ bool next(int i, Unit& u) const {
        const int np = (base.nwg - base.c + base.G - 1) / base.G;
        if (i < np) return base.next(i, u);
        const int L = (i - np) * base.G + base.c; if (L >= njobs) return false;
        const int ks = L % nsplit, un = L / nsplit; u.pm = 64 + (un >> 2); u.pn = un & 3; u.koff = ks * 256; u.nt = 4; u.tag = 1 + ks; return true;
    }
};
struct SampleOrder {
    int G, c, ntk;
    __device__ void init(int K, int G_, int c_) { G = G_; c = c_; ntk = K / BK; }
    __device__ bool next(int i, Unit& u) const { const int L = i * G + c; if (L >= 8) return false; u.pm = 64 + (L >> 2); u.pn = L & 3; u.koff = 0; u.nt = ntk; u.tag = 0; return true; }
};
__device__ __forceinline__ unsigned cvt_pk_bf16(float lo, float hi) { unsigned r; asm volatile("v_cvt_pk_bf16_f32 %0, %1, %2" : "=v"(r) : "v"(lo), "v"(hi)); return r; }

template <class Epi, class Sched>
__device__ __forceinline__ void gemm_phase(LAS unsigned char* lds, const Gemm g, const Sched& S, const Epi& E) {
    int tid_ = threadIdx.x; asm volatile("" : "+v"(tid_));
    const int tid = tid_, wid = __builtin_amdgcn_readfirstlane(tid >> 6), lane = tid & 63, wr = wid >> 2, wc = wid & 3, fr = lane & 15, fq = lane >> 4;
    const int K = g.K, lda = g.lda;
    unsigned voffA[2], voffB[2];
#pragma unroll
    for (int i = 0; i < 2; ++i) { int R, C; stage_rc(tid * 16 + i * 8192, R, C); const int Rb = Epi::PERM ? ((R & ~31) + perm32(R & 31)) : R;
        voffA[i] = (unsigned)(R * lda + C) * 2u; voffB[i] = (unsigned)(Rb * K + C) * 2u; }
    const size_t kstep = (size_t)(BK * 2);
    const size_t hstepA = (size_t)HALF * lda * 2, hstepB = (size_t)HALF * K * 2;
    const size_t tstepA = 2 * hstepA, tstepB = 2 * hstepB;
    const unsigned ldsw = (unsigned)wid * 1024u;
    const int aoff = lds_byte(wr * 64 + fr, fq * 8), boff = lds_byte(wc * 32 + fr, fq * 8);
#define PG8_SA(b, h) (((b) * 2 + (h)) * HTB)
#define PG8_SB(b, h) ((4 + (b) * 2 + (h)) * HTB)
#define PG8_STAGE(bufoff, gbase, voff) do { _Pragma("unroll") for (int _i = 0; _i < 2; ++_i) \
        __builtin_amdgcn_global_load_lds((const unsigned*)((const char*)(gbase) + (voff)[_i]), (LAS unsigned*)(lds + (bufoff) + ldsw + _i * 8192), 16, 0, 0); } while (0)
#define PG8_LDA(dst, b, h) do { _Pragma("unroll") for (int m = 0; m < 4; ++m) _Pragma("unroll") for (int k = 0; k < 2; ++k) dst[m][k] = *(const LAS bf16x8*)(lds + PG8_SA(b, h) + aoff + m * 2048 + k * 1024); } while (0)
#define PG8_LDB(dst, b, h) do { _Pragma("unroll") for (int n = 0; n < 2; ++n) _Pragma("unroll") for (int k = 0; k < 2; ++k) dst[n][k] = *(const LAS bf16x8*)(lds + PG8_SB(b, h) + boff + n * 2048 + k * 1024); } while (0)
#define PG8_MMA(ai, bj, At, Bt) do { __builtin_amdgcn_s_setprio(1); _Pragma("unroll") for (int m = 0; m < 4; ++m) _Pragma("unroll") for (int n = 0; n < 2; ++n) _Pragma("unroll") for (int k = 0; k < 2; ++k) \
        acc[ai][bj][m][n] = __builtin_amdgcn_mfma_f32_16x16x32_bf16(Bt[n][k], At[m][k], acc[ai][bj][m][n], 0, 0, 0); __builtin_amdgcn_s_setprio(0); } while (0)
#define PG8_WAIT_V(n) asm volatile("s_waitcnt vmcnt(" #n ")" ::: "memory")
#define PG8_WAIT_L(n) asm volatile("s_waitcnt lgkmcnt(" #n ")" ::: "memory")
#define PG8_BAR __builtin_amdgcn_s_barrier()
#define PG8_SCHED __builtin_amdgcn_sched_barrier(0)
    Unit cur, nxt; int ui = 0;
    if (!S.next(0, cur)) return;
    f32x4 acc[2][2][4][2];
#pragma unroll
    for (int a = 0; a < 2; ++a)
#pragma unroll
        for (int b = 0; b < 2; ++b)
#pragma unroll
            for (int m = 0; m < 4; ++m)
#pragma unroll
                for (int n = 0; n < 2; ++n) acc[a][b][m][n] = (f32x4){0.f, 0.f, 0.f, 0.f};
    bf16x8 At[4][2], B0[2][2], B1[2][2];
    const char* cA = (const char*)(cur.tag ? g.A2 : g.A) + (size_t)cur.pm * tstepA + (size_t)cur.koff * 2; const char* cB = (const char*)g.Bt + (size_t)cur.pn * tstepB + (size_t)cur.koff * 2;
    PG8_STAGE(PG8_SB(0, 0), cB, voffB); PG8_STAGE(PG8_SB(0, 1), cB + hstepB, voffB); PG8_STAGE(PG8_SA(0, 0), cA, voffA); PG8_STAGE(PG8_SA(0, 1), cA + hstepA, voffA);
    if (wr == 1) PG8_BAR;
    PG8_WAIT_V(2); PG8_BAR;
    PG8_STAGE(PG8_SB(1, 0), cB + kstep, voffB); PG8_STAGE(PG8_SA(1, 0), cA + kstep, voffA); PG8_STAGE(PG8_SB(1, 1), cB + hstepB + kstep, voffB);
    PG8_WAIT_V(6); PG8_BAR;
    for (;;) {
        const bool has_next = S.next(ui + 1, nxt);
        const char* nA = has_next ? (const char*)(nxt.tag ? g.A2 : g.A) + (size_t)nxt.pm * tstepA + (size_t)nxt.koff * 2 : cA; const char* nB = has_next ? (const char*)g.Bt + (size_t)nxt.pn * tstepB + (size_t)nxt.koff * 2 : cB;
        const int nt = cur.nt;
        for (int t = 0; t < nt; t += 2) {
            const bool last = (t == nt - 2);
            const char* a1 = cA + (size_t)(t + 1) * kstep;
            const char* a2 = last ? nA : cA + (size_t)(t + 2) * kstep; const char* b2 = last ? nB : cB + (size_t)(t + 2) * kstep;
            const char* a3 = a2 + kstep; const char* b3 = b2 + kstep;
            PG8_LDB(B0, 0, 0); PG8_LDB(B1, 0, 1); PG8_SCHED; PG8_LDA(At, 0, 0); PG8_STAGE(PG8_SA(1, 1), a1 + hstepA, voffA);
            PG8_WAIT_V(8); PG8_WAIT_L(0); PG8_BAR; PG8_MMA(0, 0, At, B0); PG8_MMA(0, 1, At, B1); PG8_BAR; PG8_SCHED;
            PG8_LDA(At, 0, 1); PG8_STAGE(PG8_SB(0, 0), b2, voffB); PG8_STAGE(PG8_SB(0, 1), b2 + hstepB, voffB); PG8_STAGE(PG8_SA(0, 0), a2, voffA);
            PG8_WAIT_V(8); PG8_WAIT_L(0); PG8_BAR; PG8_MMA(1, 0, At, B0); PG8_MMA(1, 1, At, B1); PG8_BAR; PG8_SCHED;
            PG8_LDB(B0, 1, 0); PG8_LDB(B1, 1, 1); PG8_SCHED; PG8_LDA(At, 1, 0); PG8_STAGE(PG8_SA(0, 1), a2 + hstepA, voffA);
            PG8_WAIT_V(8); PG8_WAIT_L(0); PG8_BAR; PG8_MMA(0, 0, At, B0); PG8_MMA(0, 1, At, B1); PG8_BAR; PG8_SCHED;
            PG8_LDA(At, 1, 1); PG8_STAGE(PG8_SB(1, 0), b3, voffB); PG8_STAGE(PG8_SB(1, 1), b3 + hstepB, voffB); PG8_STAGE(PG8_SA(1, 0), a3, voffA);
            PG8_WAIT_V(8); PG8_WAIT_L(0); PG8_BAR; PG8_MMA(1, 0, At, B0); PG8_MMA(1, 1, At, B1); PG8_BAR; PG8_SCHED;
        }
        if (wr == 0) PG8_BAR;
        E(acc, cur, wr, wc, fr, fq);
        if (!has_next) break;
#pragma unroll
        for (int a = 0; a < 2; ++a)
#pragma unroll
            for (int b = 0; b < 2; ++b)
#pragma unroll
                for (int m = 0; m < 4; ++m)
#pragma unroll
                    for (int n = 0; n < 2; ++n) acc[a][b][m][n] = (f32x4){0.f, 0.f, 0.f, 0.f};
        cur = nxt; cA = nA; cB = nB; ++ui;
        if (wr == 1) PG8_BAR;
    }
    PG8_WAIT_V(0);
    PG8_BAR;
#undef PG8_SA
#undef PG8_SB
#undef PG8_STAGE
#undef PG8_LDA
#undef PG8_LDB
#undef PG8_MMA
#undef PG8_WAIT_V
#undef PG8_WAIT_L
#undef PG8_BAR
#undef PG8_SCHED
}
}
using pg8::Unit;

struct EpiProj {
    static constexpr bool PERM = true;
    bf16_t* O; const float* rs;
    __device__ __forceinline__ void operator()(const f32x4 (&acc)[2][2][4][2], const Unit& u, int wr, int wc, int fr, int fq) const {
        const int row0 = u.pm * 256 + wr * 64 + fr, col0 = u.pn * 256 + wc * 32 + 8 * fq;
#pragma unroll
        for (int ai = 0; ai < 2; ++ai)
#pragma unroll
            for (int m = 0; m < 4; ++m) { const int row = row0 + ai * 128 + m * 16; const float r = rs[row]; bf16_t* rowp = O + (size_t)row * NPROJ + col0;
#pragma unroll
                for (int bj = 0; bj < 2; ++bj) { const f32x4 v0 = acc[ai][bj][m][0] * r, v1 = acc[ai][bj][m][1] * r;
                    u32x4 w; w.x = pg8::cvt_pk_bf16(v0[0], v0[1]); w.y = pg8::cvt_pk_bf16(v0[2], v0[3]); w.z = pg8::cvt_pk_bf16(v1[0], v1[1]); w.w = pg8::cvt_pk_bf16(v1[2], v1[3]);
                    *(u32x4*)(rowp + bj * 128) = w; } }
    }
};
struct EpiKV {
    static constexpr bool PERM = false;
    float* ok; float* ov; bf16_t* bk; bf16_t* bv; const float* rs;
    __device__ __forceinline__ void operator()(const f32x4 (&acc)[2][2][4][2], const Unit& u, int wr, int wc, int fr, int fq) const {
        const int row0 = u.pm * 256 + wr * 64 + fr; const int isv = u.pn >> 1; const int colt = (u.pn & 1) * 256 + wc * 32 + 4 * fq;
        float* of = isv ? ov : ok; bf16_t* ob = isv ? bv : bk;
#pragma unroll
        for (int ai = 0; ai < 2; ++ai)
#pragma unroll
            for (int m = 0; m < 4; ++m) { const int row = row0 + ai * 128 + m * 16; const float r = rs[row];
#pragma unroll
                for (int bj = 0; bj < 2; ++bj)
#pragma unroll
                    for (int n = 0; n < 2; ++n) { const f32x4 v = acc[ai][bj][m][n] * r; const int col = colt + bj * 128 + n * 16;
                        *(f32x4*)(of + (size_t)row * 512 + col) = v;
                        u32x2 w; w.x = pg8::cvt_pk_bf16(v[0], v[1]); w.y = pg8::cvt_pk_bf16(v[2], v[3]); *(u32x2*)(ob + (size_t)row * 512 + col) = w; } }
    }
};

__device__ __forceinline__ void xpose_convert(LAS float* tile, const float* __restrict__ src, int ldsrc, int K, int N, bf16_t* __restrict__ dst, const float* __restrict__ scale, int mode, int bid, int nb) {
    const int tid = otid(); const int nkt = K / 64, ntile = nkt * (N / 64);
    float cur[8];
    auto tile_src = [&](int t, int& k0, int& n0) -> int { const int kt = t % nkt, nti = t / nkt; k0 = kt * 64; n0 = nti * 64; int sc0 = n0;
        if (mode == 1) sc0 = n0 < 4096 ? n0 : n0 + 8;
        else if (mode == 2) { const int pn = n0 >> 8, bj = (n0 >> 7) & 1, i = n0 & 127; sc0 = bj * FFH + pn * 128 + i; }
        return sc0; };
    auto load_tile = [&](int t, float (&v)[8]) { int k0, n0; const int sc0 = tile_src(t, k0, n0);
#pragma unroll
        for (int i = 0; i < 8; ++i) { const int idx = tid + i * 512, r = idx >> 6, c = idx & 63; float x = src[(size_t)(k0 + r) * ldsrc + sc0 + c]; if (scale) x *= scale[k0 + r]; v[i] = x; } };
    int t = bid;
    if (t < ntile) load_tile(t, cur);
    for (; t < ntile; t += nb) {
        int k0, n0; (void)tile_src(t, k0, n0);
#pragma unroll
        for (int i = 0; i < 8; ++i) { const int idx = tid + i * 512, r = idx >> 6, c = idx & 63; tile[r * 65 + c] = cur[i]; }
        __syncthreads();
        if (t + nb < ntile) load_tile(t + nb, cur);
        { const int n = tid >> 3, kk = (tid & 7) * 8; u32x4 o;
          o.x = pk2(tile[(kk + 0) * 65 + n], tile[(kk + 1) * 65 + n]); o.y = pk2(tile[(kk + 2) * 65 + n], tile[(kk + 3) * 65 + n]);
          o.z = pk2(tile[(kk + 4) * 65 + n], tile[(kk + 5) * 65 + n]); o.w = pk2(tile[(kk + 6) * 65 + n], tile[(kk + 7) * 65 + n]);
          *(u32x4*)(dst + (size_t)(n0 + n) * K + k0 + kk) = o; }
        __syncthreads();
    }
}

__device__ __forceinline__ void phase0(LAS unsigned char* lds) {
    KA ap = kargs();
    struct { const float* in[27]; float* out; unsigned char* ws; } a; a.out = ap->out; a.ws = ap->ws;
    a.in[0] = ap->in[0]; a.in[1] = ap->in[1]; a.in[2] = ap->in[2]; a.in[9] = ap->in[9]; a.in[10] = ap->in[10]; a.in[16] = ap->in[16]; a.in[17] = ap->in[17]; a.in[18] = ap->in[18]; a.in[19] = ap->in[19]; a.in[20] = ap->in[20]; a.in[21] = ap->in[21];
    const int tid = otid(), lane = tid & 63, wid = tid >> 6, bid = obid(), nb = gridDim.x;
    unsigned char* ws = a.ws;
    LAS float* tile = (LAS float*)lds;
    xpose_convert(tile, a.in[10], INW, DM, NPROJ, (bf16_t*)(ws + WS_WIN), a.in[9], 1, bid, nb);
    xpose_convert(tile, a.in[17], DM, DM, DM, (bf16_t*)(ws + WS_WKV), a.in[16], 0, bid, nb);
    xpose_convert(tile, a.in[18], DM, 512, DM, (bf16_t*)(ws + WS_WBR), nullptr, 0, bid, nb);
    xpose_convert(tile, a.in[19], DM, 512, DM, (bf16_t*)(ws + WS_WBR) + (size_t)DM * 512, nullptr, 0, bid, nb);
    xpose_convert(tile, a.in[20], DM, 512, DM, (bf16_t*)(ws + WS_WBR) + (size_t)2 * DM * 512, nullptr, 0, bid, nb);
    xpose_convert(tile, a.in[21], DM, DM, DM, (bf16_t*)(ws + WS_WOUT), nullptr, 0, bid, nb);
    LAS float* wab = (LAS float*)lds;
    for (int i = tid; i < 8192; i += 512) { const int k = i >> 3, j = i & 7; wab[i] = a.in[9][k] * a.in[10][(size_t)k * INW + 4096 + j]; }
    __syncthreads();
    bf16_t* xb = (bf16_t*)((unsigned char*)a.out + OB_XB); bf16_t* memb = (bf16_t*)(ws + WS_MEMB);
    float* rx = (float*)(ws + WS_RX); float* rmem = (float*)(ws + WS_RMEM); float* ab = (float*)(ws + WS_AB);
    const int stride = nb * 8;
    for (int rowb = bid * 8 + wid; rowb < MT + 2048; rowb += 2 * stride) {
        f32x4 v[2][4];
#pragma unroll
        for (int u = 0; u < 2; ++u) { const int row = rowb + u * stride;
            if (row < MT + 2048) { const float* src = row < MP ? a.in[0] + (size_t)row * DM : (row < MT ? a.in[1] + (size_t)(row - MP) * DM : a.in[2] + (size_t)(row - MT) * DM);
#pragma unroll
                for (int i = 0; i < 4; ++i) v[u][i] = __builtin_nontemporal_load((const f32x4*)(src + i * 256 + lane * 4)); } }
#pragma unroll
        for (int u = 0; u < 2; ++u) { const int row = rowb + u * stride;
            if (row < MT + 2048) {
                bf16_t* dst = row < MT ? xb + (size_t)row * DM : memb + (size_t)(row - MT) * DM;
                float ss = 0.f; float dots[8];
#pragma unroll
                for (int j = 0; j < 8; ++j) dots[j] = 0.f;
#pragma unroll
                for (int i = 0; i < 4; ++i) { const int k = i * 256 + lane * 4; const f32x4 vv = v[u][i];
                    ss += vv[0] * vv[0] + vv[1] * vv[1] + vv[2] * vv[2] + vv[3] * vv[3];
                    u32x2 w; w.x = pk2(vv[0], vv[1]); w.y = pk2(vv[2], vv[3]); *(u32x2*)(dst + k) = w;
                    if (row < MT) {
#pragma unroll
                        for (int e = 0; e < 4; ++e) { const f32x4 w0 = *(const LAS f32x4*)(wab + (k + e) * 8), w1 = *(const LAS f32x4*)(wab + (k + e) * 8 + 4);
                            dots[0] += vv[e] * w0[0]; dots[1] += vv[e] * w0[1]; dots[2] += vv[e] * w0[2]; dots[3] += vv[e] * w0[3];
                            dots[4] += vv[e] * w1[0]; dots[5] += vv[e] * w1[1]; dots[6] += vv[e] * w1[2]; dots[7] += vv[e] * w1[3]; } } }
                ss = wave_sum(ss);
                const float r = rsqrtf(ss * (1.0f / DM) + EPSF);
                if (row < MT) {
#pragma unroll
                    for (int j = 0; j < 8; ++j) dots[j] = wave_sum(dots[j]);
                    if (lane == 0) { rx[row] = r;
#pragma unroll
                        for (int j = 0; j < 8; ++j) ab[(size_t)row * 8 + j] = dots[j] * r; }
                } else if (lane == 0) rmem[row - MT] = r; } }
    }
}

__device__ __forceinline__ void phase1(LAS unsigned char* lds) {
    KA ap = kargs();
    struct { float* out; unsigned char* ws; } a; a.out = ap->out; a.ws = ap->ws;
    unsigned char* ws = a.ws;
    { pg8::Gemm g{(const bf16_t*)((unsigned char*)a.out + OB_XB), (const bf16_t*)(ws + WS_WIN), MT, NPROJ, DM, DM, nullptr};
      pg8::StaticOrder S; S.init(MT, NPROJ, gridDim.x, obid());
      EpiProj E{(bf16_t*)(ws + WS_PROJ), (const float*)(ws + WS_RX)};
      pg8::gemm_phase(lds, g, S, E); }
    { pg8::Gemm g{(const bf16_t*)(ws + WS_MEMB), (const bf16_t*)(ws + WS_WKV), 2048, DM, DM, DM, nullptr};
      pg8::StaticOrder S; S.init(2048, DM, gridDim.x, gridDim.x - 1 - obid());
      EpiKV E{a.out + O_MK, a.out + O_MV, (bf16_t*)(ws + WS_MEMK), (bf16_t*)(ws + WS_MEMV), (const float*)(ws + WS_RMEM)};
      pg8::gemm_phase(lds, g, S, E); }
}

__device__ __forceinline__ float lb_of(const float* lbl, int ch) { return 1.0f / (1.0f + __expf(lbl[512 + ch] - lbl[ch])); }
__device__ __forceinline__ float softplusf_(float x) { return x > 20.f ? x : log1pf(__expf(x)); }
__device__ __forceinline__ bf16x8 ld2x4(const LAS bf16_t* p0, const LAS bf16_t* p1) {
    const bf16x4 a = *(const LAS bf16x4*)p0, b = *(const LAS bf16x4*)p1; bf16x8 r;
    r[0] = a[0]; r[1] = a[1]; r[2] = a[2]; r[3] = a[3]; r[4] = b[0]; r[5] = b[1]; r[6] = b[2]; r[7] = b[3]; return r;
}
__device__ __forceinline__ bf16x8 pkfrag(const f32x4 a, const f32x4 b) {
    u32x4 w; w.x = pk2(a[0], a[1]); w.y = pk2(a[2], a[3]); w.z = pk2(b[0], b[1]); w.w = pk2(b[2], b[3]); return *(bf16x8*)&w;
}

__device__ __forceinline__ void hg_pass1(LAS unsigned char* lds, int item, const bf16_t* proj, const float* lbl, bf16_t* dS, float* dec) {
    const int tid = otid(), lane = tid & 63, wid = tid >> 6, r = lane & 15, q = lane >> 4;
    const int d = tid & 127, seg = tid >> 7;
    const int c = item & 31, bh = item >> 5, h = bh & 3, b = bh >> 2;
    LAS bf16_t* KT = (LAS bf16_t*)lds;
    LAS bf16_t* VT = KT + 128 * 72;
    LAS float* tot = (LAS float*)(VT + 128 * 72);
    LAS bf16_t* SW = (LAS bf16_t*)(tot + 512) + wid * (16 * 136);
    const size_t row0 = (size_t)b * TSEQ + c * 64 + seg * 16;
    const bf16_t* pf = proj + row0 * NPROJ + C_HF + h * 128 + d;
    const bf16_t* pv = proj + row0 * NPROJ + C_HI + h * 128 + d;
    const float lb = lb_of(lbl, h * 128 + d);
    float Lc[16], kk[16]; float run = 0.f; unsigned vp[8];
#pragma unroll
    for (int i = 0; i < 16; ++i) { const float fz = bf2f(pf[(size_t)i * NPROJ]); const float f = lb + (1.f - lb) * sigmoidf_(fz); run += __logf(f); Lc[i] = run; kk[i] = 1.f - f; }
#pragma unroll
    for (int i = 0; i < 8; ++i) vp[i] = (unsigned)pv[(size_t)(2 * i) * NPROJ] | ((unsigned)pv[(size_t)(2 * i + 1) * NPROJ] << 16);
    tot[seg * 128 + d] = run;
    __syncthreads();
    const float t0 = tot[d], t1 = tot[128 + d], t2 = tot[256 + d], t3 = tot[384 + d];
    const float rem = (seg < 1 ? t1 : 0.f) + (seg < 2 ? t2 : 0.f) + (seg < 3 ? t3 : 0.f);
    unsigned kp[8];
#pragma unroll
    for (int i = 0; i < 8; ++i) { const float a0 = kk[2 * i] * __expf((run - Lc[2 * i]) + rem), a1 = kk[2 * i + 1] * __expf((run - Lc[2 * i + 1]) + rem); kp[i] = pk2(a0, a1); }
    *(LAS u32x4*)(KT + d * 72 + seg * 16) = (u32x4){kp[0], kp[1], kp[2], kp[3]}; *(LAS u32x4*)(KT + d * 72 + seg * 16 + 8) = (u32x4){kp[4], kp[5], kp[6], kp[7]};
    *(LAS u32x4*)(VT + d * 72 + seg * 16) = (u32x4){vp[0], vp[1], vp[2], vp[3]}; *(LAS u32x4*)(VT + d * 72 + seg * 16 + 8) = (u32x4){vp[4], vp[5], vp[6], vp[7]};
    if (seg == 0) dec[(size_t)item * 128 + d] = __expf(t0 + t1 + t2 + t3);
    __syncthreads();
    bf16_t* out = dS + (size_t)item * 16384;
#pragma unroll
    for (int n = 0; n < 8; ++n) { f32x4 acc = {0.f, 0.f, 0.f, 0.f};
#pragma unroll
        for (int ks = 0; ks < 2; ++ks) { const bf16x8 X = *(const LAS bf16x8*)(KT + (16 * n + r) * 72 + ks * 32 + q * 8), Y = *(const LAS bf16x8*)(VT + (16 * wid + r) * 72 + ks * 32 + q * 8); acc = mfma16(X, Y, acc); }
        u32x2 w; w.x = pk2(acc[0], acc[1]); w.y = pk2(acc[2], acc[3]); *(LAS u32x2*)(SW + r * 136 + 16 * n + 4 * q) = w; }
#pragma unroll
    for (int i = 0; i < 4; ++i) { const int id = lane + 64 * i, rw = id >> 4, c16 = id & 15; *(u32x4*)(out + (16 * wid + rw) * 128 + c16 * 8) = *(const LAS u32x4*)(SW + rw * 136 + c16 * 8); }
    __syncthreads();
}

__device__ __forceinline__ void hg_pass2(int task, bf16_t* dS, const float* dec, float* out_state) {
    const int bh = task >> 11, e = (task >> 4) & 127, d0 = (task & 15) * 8;
    float S[8];
#pragma unroll
    for (int j = 0; j < 8; ++j) S[j] = 0.f;
#pragma unroll 1
    for (int c8 = 0; c8 < 32; c8 += 8) {
        u32x4 raw[8]; f32x4 dc0[8], dc1[8];
#pragma unroll
        for (int i = 0; i < 8; ++i) { const size_t item = (size_t)bh * 32 + c8 + i; raw[i] = *(const u32x4*)(dS + (item * 128 + e) * 128 + d0);
            dc0[i] = *(const f32x4*)(dec + item * 128 + d0); dc1[i] = *(const f32x4*)(dec + item * 128 + d0 + 4); }
#pragma unroll
        for (int i = 0; i < 8; ++i) { const size_t item = (size_t)bh * 32 + c8 + i;
            u32x4 w; w.x = pk2(S[0], S[1]); w.y = pk2(S[2], S[3]); w.z = pk2(S[4], S[5]); w.w = pk2(S[6], S[7]); *(u32x4*)(dS + (item * 128 + e) * 128 + d0) = w;
            S[0] = dc0[i][0] * S[0] + __uint_as_float(raw[i].x << 16); S[1] = dc0[i][1] * S[1] + __uint_as_float(raw[i].x & 0xffff0000u);
            S[2] = dc0[i][2] * S[2] + __uint_as_float(raw[i].y << 16); S[3] = dc0[i][3] * S[3] + __uint_as_float(raw[i].y & 0xffff0000u);
            S[4] = dc1[i][0] * S[4] + __uint_as_float(raw[i].z << 16); S[5] = dc1[i][1] * S[5] + __uint_as_float(raw[i].z & 0xffff0000u);
            S[6] = dc1[i][2] * S[6] + __uint_as_float(raw[i].w << 16); S[7] = dc1[i][3] * S[7] + __uint_as_float(raw[i].w & 0xffff0000u); }
    }
#pragma unroll
    for (int j = 0; j < 8; ++j) out_state[((size_t)bh * 128 + d0 + j) * 128 + e] = S[j];
}

__device__ __forceinline__ void hg_pass3(LAS unsigned char* lds, int item, bf16_t* proj, const float* lbl, const bf16_t* SinT, const float* g_out, int ocol = C_HQ) {
    const int tid = otid(), lane = tid & 63, wid = tid >> 6, r = lane & 15, q = lane >> 4;
    const int d = tid & 127, seg = tid >> 7;
    const int c = item & 31, bh = item >> 5, h = bh & 3, b = bh >> 2;
    LAS bf16_t* QT = (LAS bf16_t*)lds;
    LAS bf16_t* QG = QT + 64 * 136;
    LAS bf16_t* KTB = QG + 64 * 136;
    LAS bf16_t* VT = KTB + 10 * 16 * 136;
    LAS bf16_t* AS = VT + 128 * 72;
    LAS float* tot = (LAS float*)(AS + 64 * 72);
    LAS float* ssq = tot + 512;
    const size_t row0 = (size_t)b * TSEQ + c * 64 + seg * 16;
    {
        const bf16_t* pq = proj + row0 * NPROJ + C_HQ + h * 128 + d;
        const bf16_t* pf = proj + row0 * NPROJ + C_HF + h * 128 + d;
        const bf16_t* pv = proj + row0 * NPROJ + C_HI + h * 128 + d;
        const float lb = lb_of(lbl, h * 128 + d);
        float Lc[16], kk[16], qq[16]; float run = 0.f; unsigned vp[8];
#pragma unroll
        for (int i = 0; i < 16; ++i) { const float fz = bf2f(pf[(size_t)i * NPROJ]); const float f = lb + (1.f - lb) * sigmoidf_(fz); run += __logf(f); Lc[i] = run; kk[i] = 1.f - f; qq[i] = bf2f(pq[(size_t)i * NPROJ]); }
#pragma unroll
        for (int i = 0; i < 8; ++i) vp[i] = (unsigned)pv[(size_t)(2 * i) * NPROJ] | ((unsigned)pv[(size_t)(2 * i + 1) * NPROJ] << 16);
        tot[seg * 128 + d] = run;
        __syncthreads();
        const float t0 = tot[d], t1 = tot[128 + d], t2 = tot[256 + d];
        const float R = (seg > 0 ? t0 : 0.f) + (seg > 1 ? t1 : 0.f) + (seg > 2 ? t2 : 0.f);
        const float eR = __expf(R);
        const int tri_d = seg * (seg + 1) / 2 + seg;
#pragma unroll
        for (int i = 0; i < 16; ++i) { const float qt = qq[i] * __expf(Lc[i]); const int t = seg * 16 + i;
            QT[t * 136 + d] = f2bf(qt); QG[t * 136 + d] = f2bf(qt * eR);
            KTB[(tri_d * 16 + i) * 136 + d] = f2bf(kk[i] * __expf(fminf(-Lc[i], 80.f))); }
        for (int ii = seg + 1; ii < 4; ++ii) { float mid = 0.f; if (seg < 1 && ii > 1) mid += t1; if (seg < 2 && ii > 2) mid += t2;
            const int tri = ii * (ii + 1) / 2 + seg;
#pragma unroll
            for (int i = 0; i < 16; ++i) KTB[(tri * 16 + i) * 136 + d] = f2bf(kk[i] * __expf((run - Lc[i]) + mid)); }
        *(LAS u32x4*)(VT + d * 72 + seg * 16) = (u32x4){vp[0], vp[1], vp[2], vp[3]}; *(LAS u32x4*)(VT + d * 72 + seg * 16 + 8) = (u32x4){vp[4], vp[5], vp[6], vp[7]};
    }
    __syncthreads();
#pragma unroll
    for (int rep = 0; rep < 2; ++rep) { const int blk = wid + rep * 8, bi = blk >> 2, bj = blk & 3; f32x4 acc = {0.f, 0.f, 0.f, 0.f};
        if (bj <= bi) { const int tri = bi * (bi + 1) / 2 + bj;
#pragma unroll
            for (int ks = 0; ks < 4; ++ks) { const bf16x8 X = *(const LAS bf16x8*)(KTB + (tri * 16 + r) * 136 + ks * 32 + q * 8), Y = *(const LAS bf16x8*)(QT + (16 * bi + r) * 136 + ks * 32 + q * 8); acc = mfma16(X, Y, acc); }
            if (bi == bj) {
#pragma unroll
                for (int jj = 0; jj < 4; ++jj) if (4 * q + jj > r) acc[jj] = 0.f; } }
        u32x2 w; w.x = pk2(acc[0], acc[1]); w.y = pk2(acc[2], acc[3]); *(LAS u32x2*)(AS + (16 * bi + r) * 72 + 16 * bj + 4 * q) = w; }
    __syncthreads();
    const int ti = wid & 3, eh = wid >> 2;
    f32x4 acc[4];
#pragma unroll
    for (int nn = 0; nn < 4; ++nn) { const int n = eh * 4 + nn; acc[nn] = (f32x4){0.f, 0.f, 0.f, 0.f};
#pragma unroll
        for (int ks = 0; ks < 2; ++ks) { const bf16x8 X = *(const LAS bf16x8*)(VT + (16 * n + r) * 72 + ks * 32 + q * 8), Y = *(const LAS bf16x8*)(AS + (16 * ti + r) * 72 + ks * 32 + q * 8); acc[nn] = mfma16(X, Y, acc[nn]); }
#pragma unroll
        for (int ks = 0; ks < 4; ++ks) { const bf16x8 X = *(const bf16x8*)(SinT + ((size_t)item * 128 + 16 * n + r) * 128 + ks * 32 + q * 8), Y = *(const LAS bf16x8*)(QG + (16 * ti + r) * 136 + ks * 32 + q * 8); acc[nn] = mfma16(X, Y, acc[nn]); } __builtin_amdgcn_sched_barrier(0); }
    float pss = 0.f;
#pragma unroll
    for (int nn = 0; nn < 4; ++nn) pss += acc[nn][0] * acc[nn][0] + acc[nn][1] * acc[nn][1] + acc[nn][2] * acc[nn][2] + acc[nn][3] * acc[nn][3];
    pss += __shfl_xor(pss, 16); pss += __shfl_xor(pss, 32);
    if (q == 0) ssq[(16 * ti + r) * 2 + eh] = pss;
    __syncthreads();
    { const int t = 16 * ti + r; const float rinv = rsqrtf((ssq[t * 2] + ssq[t * 2 + 1]) * (1.f / 128.f) + EPSF);
      bf16_t* prow = proj + ((size_t)b * TSEQ + c * 64 + t) * NPROJ;
#pragma unroll
      for (int nn = 0; nn < 4; ++nn) { const int e0 = 16 * (eh * 4 + nn) + 4 * q; const u32x2 gz = *(const u32x2*)(prow + C_HG + h * 128 + e0); const f32x4 gg = *(const f32x4*)(g_out + h * 128 + e0);
          const float v0 = acc[nn][0] * rinv * gg[0] * siluf_(__uint_as_float(gz.x << 16)), v1 = acc[nn][1] * rinv * gg[1] * siluf_(__uint_as_float(gz.x & 0xffff0000u));
          const float v2 = acc[nn][2] * rinv * gg[2] * siluf_(__uint_as_float(gz.y << 16)), v3 = acc[nn][3] * rinv * gg[3] * siluf_(__uint_as_float(gz.y & 0xffff0000u));
          u32x2 w; w.x = pk2(v0, v1); w.y = pk2(v2, v3); *(LAS u32x2*)(QT + t * 136 + e0) = w; } }
    __syncthreads();
#pragma unroll
    for (int i = 0; i < 2; ++i) { const int id = tid + 512 * i, rw = id >> 4, c16 = id & 15;
        *(u32x4*)(proj + ((size_t)b * TSEQ + c * 64 + rw) * NPROJ + ocol + h * 128 + c16 * 8) = *(const LAS u32x4*)(QT + rw * 136 + c16 * 8); }
    __syncthreads();
}

__device__ __forceinline__ void gdn_passA(LAS unsigned char* lds, int item, const bf16_t* proj, const float* ab, const float* wconv, const float* a_log, const float* dt_bias,
                                          bf16_t* uT, bf16_t* wo, bf16_t* kgT, bf16_t* qg, bf16_t* aqk, float* gcs, float* conv_out) {
    const int tid = otid(), lane = tid & 63, wid = tid >> 6, r = lane & 15, q = lane >> 4;
    const int c = item & 31, bh = item >> 5, h = bh & 3, b = bh >> 2;
    LAS bf16_t* Qb = (LAS bf16_t*)lds;
    LAS bf16_t* Kb = Qb + 64 * 136;
    LAS float* KF = (LAS float*)(Kb + 64 * 136);
    LAS float* VF = KF + 64 * 132;
    LAS float* Msm = VF + 64 * 132;
    LAS float* gl = Msm + 64 * 68;
    LAS float* be = gl + 64;
    LAS float* Gs = be + 64;
    LAS float* WC = Gs + 64;
    { const int nbw = (int)gridDim.x; const bool restage = (item < nbw) || ((((item - nbw) >> 5) & 3) != h);
      if (restage) { const int tid0 = otid(); for (int i = tid0; i < 1536; i += 512) { const int grp = i >> 9, j = (i >> 7) & 3, dd = i & 127; WC[i] = wconv[j * 1536 + grp * 512 + h * 128 + dd]; }
        __syncthreads(); } }
    {
        const int t = tid >> 3, dg = tid & 7, d0 = dg * 16;
        const int tg = c * 64 + t; const size_t row = (size_t)b * TSEQ + tg;
        u32x4 rawa[3][4][2]; float msk[4];
#pragma unroll
        for (int j = 0; j < 4; ++j) msk[j] = (tg - 3 + j >= 0) ? 1.f : 0.f;
#pragma unroll
        for (int grp = 0; grp < 3; ++grp)
#pragma unroll
            for (int j = 0; j < 4; ++j) { const bf16_t* pr = proj + ((tg - 3 + j >= 0) ? row - 3 + j : row) * NPROJ + C_GQKV + grp * 512 + h * 128 + d0;
                rawa[grp][j][0] = *(const u32x4*)pr; rawa[grp][j][1] = *(const u32x4*)(pr + 8); }
        asm volatile("" ::: "memory");
#pragma unroll
        for (int grp = 0; grp < 3; ++grp) { const int ch0 = grp * 512 + h * 128 + d0; float o[16];
#pragma unroll
            for (int i = 0; i < 16; ++i) o[i] = 0.f;
            u32x4 (&raw)[4][2] = rawa[grp];
#pragma unroll
            for (int j = 0; j < 4; ++j) { const u32x4 u0 = raw[j][0], u1 = raw[j][1];
                    const unsigned uu[8] = {u0.x, u0.y, u0.z, u0.w, u1.x, u1.y, u1.z, u1.w};
#pragma unroll
                    for (int i = 0; i < 8; ++i) { const f32x2 wv = *(const LAS f32x2*)(WC + (grp * 4 + j) * 128 + d0 + 2 * i) * msk[j]; const float lo = __uint_as_float(uu[i] << 16), hi = __uint_as_float(uu[i] & 0xffff0000u);
                        o[2 * i] += wv[0] * lo; o[2 * i + 1] += wv[1] * hi; }
                    asm volatile("" : "+v"(o[0]), "+v"(o[1]), "+v"(o[14]), "+v"(o[15]) :: "memory"); }
            asm volatile("" ::: "memory");
            if (c == 31 && t >= 61) {
                const bf16_t* pr = proj + row * NPROJ + C_GQKV + ch0; const u32x4 u0 = *(const u32x4*)pr, u1 = *(const u32x4*)(pr + 8); const unsigned uu[8] = {u0.x, u0.y, u0.z, u0.w, u1.x, u1.y, u1.z, u1.w};
#pragma unroll
                for (int i = 0; i < 8; ++i) { conv_out[((size_t)b * 3 + (t - 61)) * 1536 + ch0 + 2 * i] = __uint_as_float(uu[i] << 16); conv_out[((size_t)b * 3 + (t - 61)) * 1536 + ch0 + 2 * i + 1] = __uint_as_float(uu[i] & 0xffff0000u); } }
#pragma unroll
            for (int i = 0; i < 16; ++i) o[i] = siluf_(o[i]);
            if (grp < 2) {
                float sq = 0.f;
#pragma unroll
                for (int i = 0; i < 16; ++i) sq += o[i] * o[i];
                sq += __shfl_xor(sq, 1); sq += __shfl_xor(sq, 2); sq += __shfl_xor(sq, 4);
                const float rn = rsqrtf(sq + EPSF) * (grp == 0 ? 0.08838834764831845f : 1.0f);
                unsigned pp[8];
#pragma unroll
                for (int i = 0; i < 16; ++i) o[i] *= rn;
#pragma unroll
                for (int i = 0; i < 8; ++i) pp[i] = pk2(o[2 * i], o[2 * i + 1]);
                LAS bf16_t* dstb = (grp == 0 ? Qb : Kb) + t * 136 + d0;
                *(LAS u32x4*)dstb = (u32x4){pp[0], pp[1], pp[2], pp[3]}; *(LAS u32x4*)(dstb + 8) = (u32x4){pp[4], pp[5], pp[6], pp[7]};
                if (grp == 1) {
#pragma unroll
                    for (int i = 0; i < 4; ++i) *(LAS f32x4*)(KF + t * 132 + d0 + 4 * i) = (f32x4){o[4 * i], o[4 * i + 1], o[4 * i + 2], o[4 * i + 3]}; }
            } else {
#pragma unroll
                for (int i = 0; i < 4; ++i) *(LAS f32x4*)(VF + t * 132 + d0 + 4 * i) = (f32x4){o[4 * i], o[4 * i + 1], o[4 * i + 2], o[4 * i + 3]}; }
            asm volatile("" ::: "memory"); }
        if (dg == 0) { KA ap2 = kargs(); const float* ab2 = (const float*)(ap2->ws + WS_AB); const float ar = ab2[row * 8 + h], br = ab2[row * 8 + 4 + h]; be[t] = sigmoidf_(br); gl[t] = -__expf(ap2->in[12][h]) * softplusf_(ar + ap2->in[13][h]); }
    }
    __syncthreads();
    { float g = gl[lane];
#pragma unroll
        for (int o = 1; o < 64; o <<= 1) { const float v = __shfl_up(g, o); if (lane >= o) g += v; }
        Gs[lane] = g; }
    {
        const int ti = wid >> 1; const int t = 16 * ti + r; const float Gt = Gs[t], bet = be[t];
#pragma unroll
        for (int sx = 0; sx < 2; ++sx) { const int sj = (wid & 1) * 2 + sx; f32x4 aK = {0.f, 0.f, 0.f, 0.f}, aQ = {0.f, 0.f, 0.f, 0.f};
            if (sj <= ti) {
#pragma unroll
                for (int ks = 0; ks < 4; ++ks) { const bf16x8 X = *(const LAS bf16x8*)(Kb + (16 * sj + r) * 136 + ks * 32 + q * 8);
                    const bf16x8 Y1 = *(const LAS bf16x8*)(Kb + (16 * ti + r) * 136 + ks * 32 + q * 8), Y2 = *(const LAS bf16x8*)(Qb + (16 * ti + r) * 136 + ks * 32 + q * 8);
                    aK = mfma16(X, Y1, aK); aQ = mfma16(X, Y2, aQ); } }
            f32x4 mv, av;
#pragma unroll
            for (int jj = 0; jj < 4; ++jj) { const int s = 16 * sj + 4 * q + jj; const float dcy = (s <= t) ? __expf(Gt - Gs[s]) : 0.f; mv[jj] = (s < t) ? bet * dcy * aK[jj] : 0.f; av[jj] = dcy * aQ[jj]; }
            *(LAS f32x4*)(Msm + t * 68 + 16 * sj + 4 * q) = mv;
            u32x2 w; w.x = pk2(av[0], av[1]); w.y = pk2(av[2], av[3]); *(u32x2*)(aqk + (size_t)item * 4096 + t * 64 + 16 * sj + 4 * q) = w; }
    }
    __syncthreads();
    const float GC = Gs[63];
    if (tid < 256) {
        const int col = tid; float X[64];
        const LAS float* rsrc = (col < 128) ? VF + col : KF + (col - 128);
#pragma unroll
        for (int blk = 0; blk < 4; ++blk) { float a[16];
#pragma unroll
            for (int rr = 0; rr < 16; ++rr) { const int t = 16 * blk + rr; a[rr] = rsrc[t * 132] * be[t] * (col < 128 ? 1.f : __expf(Gs[t])); }
#pragma unroll
            for (int s4 = 0; s4 < 16 * blk; s4 += 4) {
#pragma unroll
                for (int rr = 0; rr < 16; ++rr) { const f32x4 m = *(const LAS f32x4*)(Msm + (16 * blk + rr) * 68 + s4);
                    a[rr] -= m[0] * X[s4]; a[rr] -= m[1] * X[s4 + 1]; a[rr] -= m[2] * X[s4 + 2]; a[rr] -= m[3] * X[s4 + 3]; }
                asm volatile("" ::: "memory"); }
#pragma unroll
            for (int rr = 0; rr < 16; ++rr) { const int t = 16 * blk + rr; float av = a[rr];
#pragma unroll
                for (int s4 = 16 * blk; s4 < t; s4 += 4) { const f32x4 m = *(const LAS f32x4*)(Msm + t * 68 + s4);
#pragma unroll
                    for (int jj = 0; jj < 4; ++jj) if (s4 + jj < t) av -= m[jj] * X[s4 + jj]; }
                asm volatile("" : "+v"(av) :: "memory"); X[t] = av; } }
        if (col < 128) { bf16_t* dst = uT + (size_t)item * 8192 + col * 64;
#pragma unroll
            for (int i = 0; i < 8; ++i) { u32x4 w; w.x = pk2(X[8 * i], X[8 * i + 1]); w.y = pk2(X[8 * i + 2], X[8 * i + 3]); w.z = pk2(X[8 * i + 4], X[8 * i + 5]); w.w = pk2(X[8 * i + 6], X[8 * i + 7]); *(u32x4*)(dst + 8 * i) = w; } }
        else { bf16_t* dst = wo + (size_t)item * 8192 + (col - 128);
#pragma unroll
            for (int t = 0; t < 64; ++t) dst[t * 128] = f2bf(X[t]); }
    } else {
        const int tt = tid - 256;
#pragma unroll
        for (int i = 0; i < 4; ++i) { const int ch = tt + i * 256, t = ch >> 4, d8 = (ch & 15) * 8; const u32x4 raw = *(const LAS u32x4*)(Qb + t * 136 + d8); const float eg = __expf(Gs[t]);
            u32x4 w; w.x = pk2(__uint_as_float(raw.x << 16) * eg, __uint_as_float(raw.x & 0xffff0000u) * eg); w.y = pk2(__uint_as_float(raw.y << 16) * eg, __uint_as_float(raw.y & 0xffff0000u) * eg);
            w.z = pk2(__uint_as_float(raw.z << 16) * eg, __uint_as_float(raw.z & 0xffff0000u) * eg); w.w = pk2(__uint_as_float(raw.w << 16) * eg, __uint_as_float(raw.w & 0xffff0000u) * eg);
            *(u32x4*)(qg + (size_t)item * 8192 + t * 128 + d8) = w; }
        { const int d = tt & 127, hf = tt >> 7; bf16_t* dst = kgT + (size_t)item * 8192 + d * 64 + hf * 32;
#pragma unroll
          for (int i = 0; i < 4; ++i) { float v[8];
#pragma unroll
              for (int j = 0; j < 8; ++j) { const int t = hf * 32 + i * 8 + j; v[j] = KF[t * 132 + d] * __expf(GC - Gs[t]); }
              u32x4 w; w.x = pk2(v[0], v[1]); w.y = pk2(v[2], v[3]); w.z = pk2(v[4], v[5]); w.w = pk2(v[6], v[7]); *(u32x4*)(dst + i * 8) = w; } }
        if (tt == 0) gcs[item] = __expf(GC);
    }
    __syncthreads();
}

__device__ __forceinline__ void gdn_passB(LAS unsigned char* lds, int bh, bf16_t* uT, bf16_t* wo, bf16_t* kgT, const float* gcs, float* out_state) {
    const int tid = otid(), lane = tid & 63, wid = tid >> 6, r = lane & 15, q = lane >> 4;
    const int e0 = 16 * wid;
    constexpr int BUF = 64 * 136 + 128 * 72;
    LAS bf16_t* L0 = (LAS bf16_t*)lds;
    LAS bf16_t* SW = L0 + 2 * BUF + wid * (16 * 136 + 16 * 72);
    LAS bf16_t* VW = SW + 16 * 136;
    u32x4 pw[2][2], pk[2][2]; u32x2 pu[2][4];
    const int rw0 = tid >> 4, cw = (tid & 15) * 8;
    const int rk0 = tid >> 3, ck = (tid & 7) * 8;
#define GB_LOAD(S_, item_) do { const size_t it_ = (size_t)(item_); \
        pw[S_][0] = *(const u32x4*)(wo + it_ * 8192 + rw0 * 128 + cw); pw[S_][1] = *(const u32x4*)(wo + it_ * 8192 + (rw0 + 32) * 128 + cw); \
        pk[S_][0] = *(const u32x4*)(kgT + it_ * 8192 + rk0 * 64 + ck); pk[S_][1] = *(const u32x4*)(kgT + it_ * 8192 + (rk0 + 64) * 64 + ck); \
        _Pragma("unroll") for (int ti_ = 0; ti_ < 4; ++ti_) pu[S_][ti_] = *(const u32x2*)(uT + it_ * 8192 + (e0 + r) * 64 + 16 * ti_ + 4 * q); } while (0)
#define GB_STORE(S_, buf_) do { LAS bf16_t* W_ = L0 + (buf_) * BUF; LAS bf16_t* K_ = W_ + 64 * 136; \
        *(LAS u32x4*)(W_ + rw0 * 136 + cw) = pw[S_][0]; *(LAS u32x4*)(W_ + (rw0 + 32) * 136 + cw) = pw[S_][1]; \
        *(LAS u32x4*)(K_ + rk0 * 72 + ck) = pk[S_][0]; *(LAS u32x4*)(K_ + (rk0 + 64) * 72 + ck) = pk[S_][1]; } while (0)
    const float gcl = (lane < 32) ? gcs[bh * 32 + lane] : 0.f;
    u32x2 ucur[4], unext[4];
    GB_LOAD(0, bh * 32);
    GB_LOAD(1, bh * 32 + 1);
    GB_STORE(0, 0);
#pragma unroll
    for (int ti = 0; ti < 4; ++ti) ucur[ti] = pu[0][ti];
    GB_LOAD(0, bh * 32 + 2);
    f32x4 Sacc[8];
#pragma unroll
    for (int i = 0; i < 8; ++i) Sacc[i] = (f32x4){0.f, 0.f, 0.f, 0.f};
    asm volatile("s_waitcnt lgkmcnt(0)" ::: "memory"); __builtin_amdgcn_s_barrier(); asm volatile("" ::: "memory");
#define GB_STEP(c_, S1_) do { const int c = (c_); const size_t item = (size_t)bh * 32 + c; \
        const LAS bf16_t* W = L0 + (c & 1) * BUF; const LAS bf16_t* KGT = W + 64 * 136; \
        if (c < 31) { GB_STORE(S1_, (c + 1) & 1); _Pragma("unroll") for (int ti = 0; ti < 4; ++ti) unext[ti] = pu[S1_][ti]; if (c < 29) GB_LOAD(S1_, item + 3); } \
        const float gc = __shfl(gcl, c); \
        bf16x8 Sf[4]; \
        _Pragma("unroll") for (int ks = 0; ks < 4; ++ks) Sf[ks] = pkfrag(Sacc[2 * ks], Sacc[2 * ks + 1]); \
        { _Pragma("unroll") for (int ks = 0; ks < 4; ++ks) { const u32x4 raw = *(const u32x4*)&Sf[ks]; *(LAS u32x2*)(SW + r * 136 + 32 * ks + 4 * q) = (u32x2){raw.x, raw.y}; *(LAS u32x2*)(SW + r * 136 + 32 * ks + 16 + 4 * q) = (u32x2){raw.z, raw.w}; } \
          bf16_t* dst = (wid < 4 ? wo + item * 8192 + e0 * 128 : kgT + item * 8192 + (e0 - 64) * 128); \
          _Pragma("unroll") for (int i = 0; i < 4; ++i) { const int id = lane + 64 * i, rw = id >> 4, c16 = id & 15; *(u32x4*)(dst + rw * 128 + c16 * 8) = *(const LAS u32x4*)(SW + rw * 136 + c16 * 8); } } \
        f32x4 P[4]; \
        _Pragma("unroll") for (int ti = 0; ti < 4; ++ti) P[ti] = (f32x4){0.f, 0.f, 0.f, 0.f}; \
        _Pragma("unroll") for (int ks = 0; ks < 4; ++ks) \
            _Pragma("unroll") for (int ti = 0; ti < 4; ++ti) { const LAS bf16_t* pwp = W + (16 * ti + r) * 136 + 32 * ks + 4 * q; P[ti] = mfma16(ld2x4(pwp, pwp + 16), Sf[ks], P[ti]); } \
        f32x4 vn[4]; \
        _Pragma("unroll") for (int ti = 0; ti < 4; ++ti) { const u32x2 uu = ucur[ti]; \
            vn[ti][0] = __uint_as_float(uu.x << 16) - P[ti][0]; vn[ti][1] = __uint_as_float(uu.x & 0xffff0000u) - P[ti][1]; \
            vn[ti][2] = __uint_as_float(uu.y << 16) - P[ti][2]; vn[ti][3] = __uint_as_float(uu.y & 0xffff0000u) - P[ti][3]; \
            u32x2 w; w.x = pk2(vn[ti][0], vn[ti][1]); w.y = pk2(vn[ti][2], vn[ti][3]); *(LAS u32x2*)(VW + r * 72 + 16 * ti + 4 * q) = w; } \
        { bf16_t* dstv = uT + item * 8192 + e0 * 64; \
          _Pragma("unroll") for (int i = 0; i < 2; ++i) { const int id = lane + 64 * i, rw = id >> 3, c8 = id & 7; *(u32x4*)(dstv + rw * 64 + c8 * 8) = *(const LAS u32x4*)(VW + rw * 72 + c8 * 8); } } \
        bf16x8 Vf[2]; \
        Vf[0] = pkfrag(vn[0], vn[1]); Vf[1] = pkfrag(vn[2], vn[3]); \
        _Pragma("unroll") for (int dt = 0; dt < 8; ++dt) Sacc[dt] = Sacc[dt] * gc; \
        _Pragma("unroll") for (int k2 = 0; k2 < 2; ++k2) \
            _Pragma("unroll") for (int dt = 0; dt < 8; ++dt) { const LAS bf16_t* pp = KGT + (16 * dt + r) * 72 + 32 * k2 + 4 * q; Sacc[dt] = mfma16(ld2x4(pp, pp + 16), Vf[k2], Sacc[dt]); } \
        _Pragma("unroll") for (int ti = 0; ti < 4; ++ti) ucur[ti] = unext[ti]; \
        asm volatile("s_waitcnt lgkmcnt(0)" ::: "memory"); __builtin_amdgcn_s_barrier(); asm volatile("" ::: "memory"); } while (0)
#pragma unroll 1
    for (int c2 = 0; c2 < 32; c2 += 2) { GB_STEP(c2, 1); GB_STEP(c2 + 1, 0); }
#undef GB_STEP
#undef GB_LOAD
#undef GB_STORE
#pragma unroll
    for (int dt = 0; dt < 8; ++dt)
#pragma unroll
        for (int jj = 0; jj < 4; ++jj) out_state[((size_t)bh * 128 + 16 * dt + 4 * q + jj) * 128 + e0 + r] = Sacc[dt][jj];
    __syncthreads();
}
__device__ __forceinline__ void gdn_passC(LAS unsigned char* lds, int item, bf16_t* proj, const bf16_t* vnT, const bf16_t* st_lo, const bf16_t* st_hi, const bf16_t* qg, const bf16_t* aqk, const float* g_out, int ocol = C_GQKV) {
    const int tid = otid(), lane = tid & 63, wid = tid >> 6, r = lane & 15, q = lane >> 4;
    const int c = item & 31, bh = item >> 5, h = bh & 3, b = bh >> 2;
    LAS float* ssq = (LAS float*)lds;
    LAS bf16_t* OT = (LAS bf16_t*)(lds + 1024);
    const int ti = wid & 3, eh = wid >> 2;
    const bf16_t* ST = (eh == 0 ? st_lo : st_hi) + (size_t)item * 8192;
    bf16x8 Yq[4], Ya[2];
#pragma unroll
    for (int ks = 0; ks < 4; ++ks) Yq[ks] = *(const bf16x8*)(qg + (size_t)item * 8192 + (16 * ti + r) * 128 + ks * 32 + q * 8);
#pragma unroll
    for (int ks = 0; ks < 2; ++ks) Ya[ks] = *(const bf16x8*)(aqk + (size_t)item * 4096 + (16 * ti + r) * 64 + ks * 32 + q * 8);
    f32x4 acc[4];
#pragma unroll
    for (int nn = 0; nn < 4; ++nn) { const int n = eh * 4 + nn; acc[nn] = (f32x4){0.f, 0.f, 0.f, 0.f};
#pragma unroll
        for (int ks = 0; ks < 4; ++ks) { const bf16x8 X = *(const bf16x8*)(ST + (16 * nn + r) * 128 + ks * 32 + q * 8); acc[nn] = mfma16(X, Yq[ks], acc[nn]); }
#pragma unroll
        for (int ks = 0; ks < 2; ++ks) { const bf16x8 X = *(const bf16x8*)(vnT + (size_t)item * 8192 + (16 * n + r) * 64 + ks * 32 + q * 8); acc[nn] = mfma16(X, Ya[ks], acc[nn]); } }
    float pss = 0.f;
#pragma unroll
    for (int nn = 0; nn < 4; ++nn) pss += acc[nn][0] * acc[nn][0] + acc[nn][1] * acc[nn][1] + acc[nn][2] * acc[nn][2] + acc[nn][3] * acc[nn][3];
    pss += __shfl_xor(pss, 16); pss += __shfl_xor(pss, 32);
    if (q == 0) ssq[(16 * ti + r) * 2 + eh] = pss;
    __syncthreads();
    { const int t = 16 * ti + r; const float rinv = rsqrtf((ssq[t * 2] + ssq[t * 2 + 1]) * (1.f / 128.f) + EPSF);
      bf16_t* prow = proj + ((size_t)b * TSEQ + c * 64 + t) * NPROJ;
#pragma unroll
      for (int nn = 0; nn < 4; ++nn) { const int e0 = 16 * (eh * 4 + nn) + 4 * q; const u32x2 gz = *(const u32x2*)(prow + C_GZ + h * 128 + e0); const f32x4 gg = *(const f32x4*)(g_out + e0);
          const float v0 = acc[nn][0] * rinv * gg[0] * siluf_(__uint_as_float(gz.x << 16)), v1 = acc[nn][1] * rinv * gg[1] * siluf_(__uint_as_float(gz.x & 0xffff0000u));
          const float v2 = acc[nn][2] * rinv * gg[2] * siluf_(__uint_as_float(gz.y << 16)), v3 = acc[nn][3] * rinv * gg[3] * siluf_(__uint_as_float(gz.y & 0xffff0000u));
          u32x2 w; w.x = pk2(v0, v1); w.y = pk2(v2, v3); *(LAS u32x2*)(OT + t * 136 + e0) = w; } }
    __syncthreads();
#pragma unroll
    for (int i = 0; i < 2; ++i) { const int id = tid + 512 * i, rw = id >> 4, c16 = id & 15;
        *(u32x4*)(proj + ((size_t)b * TSEQ + c * 64 + rw) * NPROJ + ocol + h * 128 + c16 * 8) = *(const LAS u32x4*)(OT + rw * 136 + c16 * 8); }
    __syncthreads();
}

__device__ __forceinline__ void hg_sample(LAS unsigned char* lds, int it, bf16_t* proj, const float* lbl, const float* st_in, float* st_out, const float* g_out, bf16_t* oproj) {
    const int tid = otid(), lane = tid & 63, wid = tid >> 6, sub = tid >> 8, hf = (tid >> 7) & 1, e = tid & 127;
    const int bh = it * 2 + sub, b = bh >> 2, h = bh & 3;
    LAS float* qs = (LAS float*)lds; LAS float* fs = qs + 1024; LAS float* ks = fs + 1024; LAS float* red = ks + 1024; LAS float* po = red + 64;
    float v[4], gt[4];
    { const float lb = lb_of(lbl, h * 128 + e);
#pragma unroll
      for (int t = 0; t < 4; ++t) { const bf16_t* pr = proj + ((size_t)MP + b * 4 + t) * NPROJ + h * 128 + e; const float f = lb + (1.f - lb) * sigmoidf_(bf2f(pr[C_HF]));
          if (hf == 0) { qs[(sub * 4 + t) * 128 + e] = bf2f(pr[C_HQ]); fs[(sub * 4 + t) * 128 + e] = f; ks[(sub * 4 + t) * 128 + e] = 1.f - f; }
          v[t] = bf2f(pr[C_HI]); gt[t] = bf2f(pr[C_HG]); } }
    __syncthreads();
    float S[64]; const float* sp = st_in + (size_t)bh * 16384 + (size_t)hf * 8192 + e;
#pragma unroll
    for (int d8 = 0; d8 < 64; d8 += 8) {
#pragma unroll
        for (int j = 0; j < 8; ++j) S[d8 + j] = __builtin_nontemporal_load(sp + j * 128);
        sp += 1024; asm volatile("" ::: "memory"); }
    float ot[4];
#pragma unroll
    for (int t = 0; t < 4; ++t) { float o = 0.f; asm volatile("" ::: "memory"); const LAS float* fq = fs + (sub * 4 + t) * 128 + hf * 64; const LAS float* kq = ks + (sub * 4 + t) * 128 + hf * 64; const LAS float* qq = qs + (sub * 4 + t) * 128 + hf * 64;
#pragma unroll
        for (int d4 = 0; d4 < 64; d4 += 4) { const f32x4 f4 = *(const LAS f32x4*)(fq + d4), k4 = *(const LAS f32x4*)(kq + d4), q4 = *(const LAS f32x4*)(qq + d4);
#pragma unroll
            for (int j = 0; j < 4; ++j) { S[d4 + j] = f4[j] * S[d4 + j] + k4[j] * v[t]; o += q4[j] * S[d4 + j]; }
            asm volatile("" : "+v"(S[d4]), "+v"(S[d4 + 1]), "+v"(S[d4 + 2]), "+v"(S[d4 + 3]), "+v"(o) :: "memory"); }
        ot[t] = o; }
    float* op = st_out + (size_t)bh * 16384 + (size_t)hf * 8192 + e;
#pragma unroll
    for (int d8 = 0; d8 < 64; d8 += 8) {
#pragma unroll
        for (int j = 0; j < 8; ++j) __builtin_nontemporal_store(S[d8 + j], op + j * 128);
        op += 1024; asm volatile("" ::: "memory"); }
#pragma unroll
    for (int t = 0; t < 4; ++t) po[((sub * 2 + hf) * 4 + t) * 128 + e] = ot[t];
    __syncthreads();
#pragma unroll
    for (int t = 0; t < 4; ++t) { ot[t] = po[((sub * 2) * 4 + t) * 128 + e] + po[((sub * 2 + 1) * 4 + t) * 128 + e]; const float p = wave_sum(ot[t] * ot[t]); if (lane == 0 && hf == 0) red[(sub * 4 + t) * 4 + (wid & 1)] = p; }
    __syncthreads();
    if (hf == 0) { const float gg = g_out[h * 128 + e];
#pragma unroll
        for (int t = 0; t < 4; ++t) { const float tot = red[(sub * 4 + t) * 4] + red[(sub * 4 + t) * 4 + 1]; const float rinv = rsqrtf(tot * (1.f / 128.f) + EPSF);
            oproj[((size_t)MP + b * 4 + t) * NPROJ + C_HQ + h * 128 + e] = f2bf(ot[t] * rinv * gg * siluf_(gt[t])); } }
    __syncthreads();
}
__device__ __forceinline__ void gdn_sample(LAS unsigned char* lds, int it, bf16_t* proj, const float* ab, const float* wconv, const float* a_log, const float* dt_bias, const float* cv_in, float* cv_out,
                                           const float* st_in, float* st_out, const float* g_out, bf16_t* oproj) {
    const int tid = otid(), lane = tid & 63, wid = tid >> 6, sub = tid >> 8, hf = (tid >> 7) & 1, e = tid & 127;
    const int bh = it * 2 + sub, b = bh >> 2, h = bh & 3;
    LAS float* qs = (LAS float*)lds; LAS float* ks = qs + 1024; LAS float* red = ks + 1024; LAS float* po = red + 64;
    float x[3][4];
#pragma unroll
    for (int grp = 0; grp < 3; ++grp) { const int ch = grp * 512 + h * 128 + e; float u[7], w[4];
#pragma unroll
        for (int j = 0; j < 3; ++j) u[j] = cv_in[((size_t)b * 3 + j) * 1536 + ch];
#pragma unroll
        for (int t = 0; t < 4; ++t) u[3 + t] = bf2f(proj[((size_t)MP + b * 4 + t) * NPROJ + C_GQKV + ch]);
#pragma unroll
        for (int j = 0; j < 4; ++j) w[j] = wconv[j * 1536 + ch];
#pragma unroll
        for (int t = 0; t < 4; ++t) x[grp][t] = siluf_(w[0] * u[t] + w[1] * u[t + 1] + w[2] * u[t + 2] + w[3] * u[t + 3]);
        if (hf == 0) {
#pragma unroll
            for (int j = 0; j < 3; ++j) cv_out[((size_t)b * 3 + j) * 1536 + ch] = u[4 + j]; } }
#pragma unroll
    for (int t = 0; t < 4; ++t) { const float pq = wave_sum(x[0][t] * x[0][t]), pk = wave_sum(x[1][t] * x[1][t]);
        if (lane == 0 && hf == 0) { red[(sub * 8 + t) * 4 + (wid & 1)] = pq; red[(sub * 8 + 4 + t) * 4 + (wid & 1)] = pk; } }
    __syncthreads();
    float beta[4], av[4], zt[4];
#pragma unroll
    for (int t = 0; t < 4; ++t) { const float sq = red[(sub * 8 + t) * 4] + red[(sub * 8 + t) * 4 + 1], sk = red[(sub * 8 + 4 + t) * 4] + red[(sub * 8 + 4 + t) * 4 + 1];
        if (hf == 0) { qs[(sub * 4 + t) * 128 + e] = x[0][t] * rsqrtf(sq + EPSF) * 0.08838834764831845f; ks[(sub * 4 + t) * 128 + e] = x[1][t] * rsqrtf(sk + EPSF); }
        const size_t row = (size_t)MP + b * 4 + t; beta[t] = sigmoidf_(ab[row * 8 + 4 + h]); av[t] = __expf(-__expf(a_log[h]) * softplusf_(ab[row * 8 + h] + dt_bias[h]));
        zt[t] = bf2f(proj[row * NPROJ + C_GZ + h * 128 + e]); }
    __syncthreads();
    float S[64]; const float* sp = st_in + (size_t)bh * 16384 + (size_t)hf * 8192 + e;
#pragma unroll
    for (int d8 = 0; d8 < 64; d8 += 8) {
#pragma unroll
        for (int j = 0; j < 8; ++j) S[d8 + j] = __builtin_nontemporal_load(sp + j * 128);
        sp += 1024; asm volatile("" ::: "memory"); }
    float ot[4];
#pragma unroll
    for (int t = 0; t < 4; ++t) { const LAS float* kq = ks + (sub * 4 + t) * 128 + hf * 64; const LAS float* qq = qs + (sub * 4 + t) * 128 + hf * 64; float kS = 0.f;
#pragma unroll
        for (int d4 = 0; d4 < 64; d4 += 4) { const f32x4 k4 = *(const LAS f32x4*)(kq + d4);
#pragma unroll
            for (int j = 0; j < 4; ++j) kS += k4[j] * S[d4 + j];
            asm volatile("" : "+v"(kS) :: "memory"); }
        po[((sub * 2 + hf) * 4 + t) * 128 + e] = kS;
        __syncthreads();
        kS = po[((sub * 2) * 4 + t) * 128 + e] + po[((sub * 2 + 1) * 4 + t) * 128 + e];
        const float a = av[t], vn = beta[t] * (x[2][t] - a * kS); float o = 0.f;
#pragma unroll
        for (int d4 = 0; d4 < 64; d4 += 4) { const f32x4 k4 = *(const LAS f32x4*)(kq + d4), q4 = *(const LAS f32x4*)(qq + d4);
#pragma unroll
            for (int j = 0; j < 4; ++j) { S[d4 + j] = a * S[d4 + j] + k4[j] * vn; o += q4[j] * S[d4 + j]; }
            asm volatile("" : "+v"(S[d4]), "+v"(S[d4 + 1]), "+v"(S[d4 + 2]), "+v"(S[d4 + 3]), "+v"(o) :: "memory"); }
        ot[t] = o; }
    float* op = st_out + (size_t)bh * 16384 + (size_t)hf * 8192 + e;
#pragma unroll
    for (int d8 = 0; d8 < 64; d8 += 8) {
#pragma unroll
        for (int j = 0; j < 8; ++j) __builtin_nontemporal_store(S[d8 + j], op + j * 128);
        op += 1024; asm volatile("" ::: "memory"); }
    __syncthreads();
#pragma unroll
    for (int t = 0; t < 4; ++t) po[((sub * 2 + hf) * 4 + t) * 128 + e] = ot[t];
    __syncthreads();
#pragma unroll
    for (int t = 0; t < 4; ++t) { ot[t] = po[((sub * 2) * 4 + t) * 128 + e] + po[((sub * 2 + 1) * 4 + t) * 128 + e]; const float p = wave_sum(ot[t] * ot[t]); if (lane == 0 && hf == 0) red[(sub * 8 + t) * 4 + (wid & 1)] = p; }
    __syncthreads();
    if (hf == 0) { const float gg = g_out[e];
#pragma unroll
        for (int t = 0; t < 4; ++t) { const float tot = red[(sub * 8 + t) * 4] + red[(sub * 8 + t) * 4 + 1]; const float rinv = rsqrtf(tot * (1.f / 128.f) + EPSF);
            oproj[((size_t)MP + b * 4 + t) * NPROJ + C_GQKV + h * 128 + e] = f2bf(ot[t] * rinv * gg * siluf_(zt[t])); } }
    __syncthreads();
}

template <bool SAMPLE>
__device__ __forceinline__ void attn_item(LAS unsigned char* lds, int idx, bf16_t* proj, const bf16_t* mk, const bf16_t* mv, const float* ck, const float* cv) {
    const int tid = otid(), lane = tid & 63, wid = tid >> 6, r = lane & 15, q = lane >> 4;
    LAS bf16_t* Ks = (LAS bf16_t*)lds;
    LAS bf16_t* VT = Ks + 256 * 136;
    int b, h, qc = 0;
    if (SAMPLE) { b = idx >> 2; h = idx & 3; } else { b = idx >> 6; h = (idx >> 4) & 3; qc = idx & 15; }
#pragma unroll
    for (int i = 0; i < 8; ++i) { const int ch = tid + i * 512, key = ch >> 4, dg = ch & 15; u32x4 kv, vv;
        if (SAMPLE) { const float* pk_ = ck + (((size_t)b * 256 + key) * 4 + h) * 128 + dg * 8; const float* pv_ = cv + (((size_t)b * 256 + key) * 4 + h) * 128 + dg * 8;
            const f32x4 k0 = __builtin_nontemporal_load((const f32x4*)pk_), k1 = __builtin_nontemporal_load((const f32x4*)(pk_ + 4)), v0 = __builtin_nontemporal_load((const f32x4*)pv_), v1 = __builtin_nontemporal_load((const f32x4*)(pv_ + 4));
            kv.x = pk2(k0[0], k0[1]); kv.y = pk2(k0[2], k0[3]); kv.z = pk2(k1[0], k1[1]); kv.w = pk2(k1[2], k1[3]);
            vv.x = pk2(v0[0], v0[1]); vv.y = pk2(v0[2], v0[3]); vv.z = pk2(v1[0], v1[1]); vv.w = pk2(v1[2], v1[3]); }
        else { kv = *(const u32x4*)(mk + ((size_t)b * 256 + key) * 512 + h * 128 + dg * 8); vv = *(const u32x4*)(mv + ((size_t)b * 256 + key) * 512 + h * 128 + dg * 8); }
        *(LAS u32x4*)(Ks + key * 136 + dg * 8) = kv;
        LAS bf16_t* vt = VT + (dg * 8) * 264 + key;
        vt[0] = (bf16_t)(vv.x & 0xffff); vt[264] = (bf16_t)(vv.x >> 16); vt[2 * 264] = (bf16_t)(vv.y & 0xffff); vt[3 * 264] = (bf16_t)(vv.y >> 16);
        vt[4 * 264] = (bf16_t)(vv.z & 0xffff); vt[5 * 264] = (bf16_t)(vv.z >> 16); vt[6 * 264] = (bf16_t)(vv.w & 0xffff); vt[7 * 264] = (bf16_t)(vv.w >> 16); }
    __syncthreads();
    if (!SAMPLE || wid == 0) {
        LAS bf16_t* Ksl = Ks; LAS bf16_t* VTl = VT;
        const size_t row0 = SAMPLE ? ((size_t)MP + b * 4) : ((size_t)b * TSEQ + qc * 128 + wid * 16);
        const int tq = SAMPLE ? (r & 3) : r;
        bf16_t* qrow = proj + (row0 + tq) * NPROJ + C_MQ + h * 128;
        bf16x8 Yq[4];
#pragma unroll
        for (int ks = 0; ks < 4; ++ks) Yq[ks] = *(const bf16x8*)(qrow + ks * 32 + q * 8);
        f32x4 sacc[16];
#pragma unroll
        for (int kt = 0; kt < 16; ++kt) { sacc[kt] = (f32x4){0.f, 0.f, 0.f, 0.f};
#pragma unroll
            for (int ks = 0; ks < 4; ++ks) { const bf16x8 X = *(const LAS bf16x8*)(Ksl + (16 * kt + r) * 136 + ks * 32 + q * 8); sacc[kt] = mfma16(X, Yq[ks], sacc[kt]); } __builtin_amdgcn_sched_barrier(0); }
        float m = -1e30f;
#pragma unroll
        for (int kt = 0; kt < 16; ++kt) m = fmaxf(m, fmaxf(fmaxf(sacc[kt][0], sacc[kt][1]), fmaxf(sacc[kt][2], sacc[kt][3])));
        m = fmaxf(m, __shfl_xor(m, 16)); m = fmaxf(m, __shfl_xor(m, 32));
        float sum = 0.f;
#pragma unroll
        for (int kt = 0; kt < 16; ++kt)
#pragma unroll
            for (int jj = 0; jj < 4; ++jj) { const float p = __expf((sacc[kt][jj] - m) * 0.08838834764831845f); sacc[kt][jj] = p; sum += p; }
        sum += __shfl_xor(sum, 16); sum += __shfl_xor(sum, 32);
        f32x4 oacc[8];
#pragma unroll
        for (int et = 0; et < 8; ++et) oacc[et] = (f32x4){0.f, 0.f, 0.f, 0.f};
#pragma unroll
        for (int k8 = 0; k8 < 8; ++k8) { const bf16x8 Pf = pkfrag(sacc[2 * k8], sacc[2 * k8 + 1]);
#pragma unroll
            for (int et = 0; et < 8; ++et) { const LAS bf16_t* pp = VTl + (16 * et + r) * 264 + 32 * k8 + 4 * q; oacc[et] = mfma16(ld2x4(pp, pp + 16), Pf, oacc[et]); } __builtin_amdgcn_sched_barrier(0); }
        const float inv = 1.0f / sum;
        if (!SAMPLE || r < 4) { bf16_t* orow = proj + (row0 + r) * NPROJ + C_MQ + h * 128;
#pragma unroll
            for (int et = 0; et < 8; ++et) { u32x2 w; w.x = pk2(oacc[et][0] * inv, oacc[et][1] * inv); w.y = pk2(oacc[et][2] * inv, oacc[et][3] * inv); *(u32x2*)(orow + 16 * et + 4 * q) = w; } }
    }
    __syncthreads();
}

__device__ __forceinline__ void phase2(LAS unsigned char* lds) {
    const int nb = gridDim.x;
    { KA ap = kargs(); const int bid = obid(); unsigned char* ws = ap->ws; unsigned char* ob = (unsigned char*)ap->out; float* out = ap->out; bf16_t* proj = (bf16_t*)(ws + WS_PROJ);
      for (int item = bid; item < 1024; item += nb)
        gdn_passA(lds, item, proj, (const float*)(ws + WS_AB), ap->in[11], ap->in[12], ap->in[13], (bf16_t*)(ob + OB_UT), (bf16_t*)(ob + OB_W), (bf16_t*)(ws + WS_KGT), (bf16_t*)(ws + WS_QG), (bf16_t*)(ws + WS_AQK),
                  (float*)(ws + WS_GCS), out + O_CVP); }
    { KA ap = kargs(); const int bid = obid(); unsigned char* ws = ap->ws; unsigned char* ob = (unsigned char*)ap->out; bf16_t* proj = (bf16_t*)(ws + WS_PROJ);
      for (int item = bid; item < 1024; item += nb) hg_pass1(lds, item, proj, ap->in[8], (bf16_t*)(ob + OB_DS), (float*)(ws + WS_DEC)); }
}
__device__ __forceinline__ void phase3(LAS unsigned char* lds) {
    KA ap = kargs(); const int bid = obid(), nb = gridDim.x;
    unsigned char* ws = ap->ws; unsigned char* ob = (unsigned char*)ap->out; float* out = ap->out;
    if (bid < 32) {
        gdn_passB(lds, bid, (bf16_t*)(ob + OB_UT), (bf16_t*)(ob + OB_W), (bf16_t*)(ws + WS_KGT), (const float*)(ws + WS_GCS), out + O_GDP);
    } else {
        const int tid = otid();
        { const int per = (65536 + (nb - 32) - 1) / (nb - 32); if (tid < per) { const int task = (bid - 32) * per + tid; if (task < 65536) hg_pass2(task, (bf16_t*)(ob + OB_DS), (const float*)(ws + WS_DEC), out + O_HGP); } }
        bf16_t* proj = (bf16_t*)(ws + WS_PROJ);
        for (int e = bid - 32; e < 1536; e += nb - 32) {
            if (e < 256) hg_sample(lds, e, proj, ap->in[8], ap->in[5], out + O_HGS, ap->in[14], proj);
            else if (e < 512) gdn_sample(lds, e - 256, proj, (const float*)(ws + WS_AB), ap->in[11], ap->in[12], ap->in[13], ap->in[7], out + O_CVS, ap->in[6], out + O_GDS, ap->in[15], proj);
            else if (e < 1024) attn_item<true>(lds, e - 512, proj, nullptr, nullptr, ap->in[3], ap->in[4]);
            else attn_item<false>(lds, e - 1024, proj, (const bf16_t*)(ws + WS_MEMK), (const bf16_t*)(ws + WS_MEMV), nullptr, nullptr);
        }
    }
}
template <int BR> struct EpiMerge {
    static constexpr bool PERM = false;
    float* macc; bf16_t* merged; const bf16_t* proj; bf16_t* merged_s;
    __device__ __forceinline__ void operator()(const f32x4 (&acc)[2][2][4][2], const Unit& u, int wr, int wc, int fr, int fq) const {
        const int row0 = u.pm * 256 + wr * 64 + fr, col0 = u.pn * 256 + wc * 32 + 4 * fq;
#pragma unroll
        for (int ai = 0; ai < 2; ++ai)
#pragma unroll
            for (int m = 0; m < 4; ++m) { const size_t row = (size_t)(row0 + ai * 128 + m * 16);
#pragma unroll
                for (int bj = 0; bj < 2; ++bj)
#pragma unroll
                    for (int n = 0; n < 2; ++n) { const int col = col0 + bj * 128 + n * 16; const u32x2 gz = *(const u32x2*)(proj + row * NPROJ + C_GATE + BR * 1024 + col);
                        f32x4 v; v[0] = sigmoidf_(__uint_as_float(gz.x << 16)) * acc[ai][bj][m][n][0]; v[1] = sigmoidf_(__uint_as_float(gz.x & 0xffff0000u)) * acc[ai][bj][m][n][1];
                        v[2] = sigmoidf_(__uint_as_float(gz.y << 16)) * acc[ai][bj][m][n][2]; v[3] = sigmoidf_(__uint_as_float(gz.y & 0xffff0000u)) * acc[ai][bj][m][n][3];
                        if (BR > 0) v += *(const f32x4*)(macc + row * DM + col);
                        if (BR < 2) *(f32x4*)(macc + row * DM + col) = v;
                        else { u32x2 w; w.x = pg8::cvt_pk_bf16(v[0], v[1]); w.y = pg8::cvt_pk_bf16(v[2], v[3]); *(u32x2*)((row >= MP ? merged_s - (size_t)MP * DM : merged) + row * DM + col) = w; } } }
    }
};
struct EpiOutF32 {
    static constexpr bool PERM = false;
    float* O; float* part;
    __device__ __forceinline__ void operator()(const f32x4 (&acc)[2][2][4][2], const Unit& u, int wr, int wc, int fr, int fq) const {
        const int row0 = u.pm * 256 + wr * 64 + fr, col0 = u.pn * 256 + wc * 32 + 4 * fq;
        float* base = u.tag ? part + ((size_t)(u.tag - 1) * MS - MP) * DM : O;
#pragma unroll
        for (int ai = 0; ai < 2; ++ai)
#pragma unroll
            for (int m = 0; m < 4; ++m) { const size_t row = (size_t)(row0 + ai * 128 + m * 16);
#pragma unroll
                for (int bj = 0; bj < 2; ++bj)
#pragma unroll
                    for (int n = 0; n < 2; ++n) *(f32x4*)(base + row * DM + col0 + bj * 128 + n * 16) = acc[ai][bj][m][n]; }
    }
};
struct EpiSwiGLU {
    static constexpr bool PERM = true;
    bf16_t* O; const float* rs;
    __device__ __forceinline__ void operator()(const f32x4 (&acc)[2][2][4][2], const Unit& u, int wr, int wc, int fr, int fq) const {
        const int row0 = u.pm * 256 + wr * 64 + fr, col0 = u.pn * 128 + wc * 32 + 8 * fq;
#pragma unroll
        for (int ai = 0; ai < 2; ++ai)
#pragma unroll
            for (int m = 0; m < 4; ++m) { const size_t row = (size_t)(row0 + ai * 128 + m * 16); const float r = rs[row]; float o[8];
#pragma unroll
                for (int n = 0; n < 2; ++n)
#pragma unroll
                    for (int j = 0; j < 4; ++j) { const float g = acc[ai][0][m][n][j] * r, up = acc[ai][1][m][n][j] * r; o[n * 4 + j] = siluf_(g) * up; }
                u32x4 w; w.x = pg8::cvt_pk_bf16(o[0], o[1]); w.y = pg8::cvt_pk_bf16(o[2], o[3]); w.z = pg8::cvt_pk_bf16(o[4], o[5]); w.w = pg8::cvt_pk_bf16(o[6], o[7]);
                *(u32x4*)(O + row * FFH + col0) = w; }
    }
};

template <class Sched>
__device__ __forceinline__ void merged_gemms(LAS unsigned char* lds, const Sched& S) {
    KA ap = kargs(); unsigned char* ws = ap->ws; float* macc = ap->out; const bf16_t* proj = (const bf16_t*)(ws + WS_PROJ); bf16_t* merged = (bf16_t*)(ws + WS_MERGED); bf16_t* ms = (bf16_t*)(ws + WS_MRGS);
    { pg8::Gemm g{proj + C_HQ, (const bf16_t*)(ws + WS_WBR), MT, DM, 512, NPROJ, nullptr}; EpiMerge<0> E{macc, merged, proj, ms}; pg8::gemm_phase(lds, g, S, E); }
    { pg8::Gemm g{proj + C_GQKV, (const bf16_t*)(ws + WS_WBR) + (size_t)DM * 512, MT, DM, 512, NPROJ, nullptr}; EpiMerge<1> E{macc, merged, proj, ms}; pg8::gemm_phase(lds, g, S, E); }
    { pg8::Gemm g{proj + C_MQ, (const bf16_t*)(ws + WS_WBR) + (size_t)2 * DM * 512, MT, DM, 512, NPROJ, nullptr}; EpiMerge<2> E{macc, merged, proj, ms}; pg8::gemm_phase(lds, g, S, E); }
}
__device__ __forceinline__ void phase5(LAS unsigned char* lds) {
    pg8::StaticOrder S; S.init(MP, DM, gridDim.x, obid(), 512); merged_gemms(lds, S);
}
__device__ __forceinline__ void phase4(LAS unsigned char* lds) {
    if (obid() < 8) { pg8::SampleOrder S; S.init(512, 8, obid()); merged_gemms(lds, S); return; }
    KA ap = kargs(); const int bid = obid() - 8, nb = gridDim.x - 8;
    unsigned char* ws = ap->ws; unsigned char* ob = (unsigned char*)ap->out;
#if PROBE_DRY & 4
    for (int item = bid; item < 1024; item += nb) gdn_passC(lds, item, (bf16_t*)(ws + WS_PROJ), (const bf16_t*)(ob + OB_UT), (const bf16_t*)(ob + OB_W), (const bf16_t*)(ws + WS_KGT), (const bf16_t*)(ws + WS_QG), (const bf16_t*)(ws + WS_AQK), ap->in[15], C_GQKV + 1024);
#endif
#if PROBE_DRY & 8
    for (int item = bid; item < 1024; item += nb) hg_pass3(lds, item, (bf16_t*)(ws + WS_PROJ), ap->in[8], (const bf16_t*)(ob + OB_DS), ap->in[14], C_GQKV + 512);
#endif
    for (int item = bid; item < 1024; item += nb) gdn_passC(lds, item, (bf16_t*)(ws + WS_PROJ), (const bf16_t*)(ob + OB_UT), (const bf16_t*)(ob + OB_W), (const bf16_t*)(ws + WS_KGT), (const bf16_t*)(ws + WS_QG), (const bf16_t*)(ws + WS_AQK), ap->in[15]);
    for (int item = bid; item < 1024; item += nb) hg_pass3(lds, item, (bf16_t*)(ws + WS_PROJ), ap->in[8], (const bf16_t*)(ob + OB_DS), ap->in[14]);
}

__device__ __forceinline__ void phase6(LAS unsigned char* lds) {
    KA ap = kargs(); unsigned char* ws = ap->ws;
    pg8::Gemm g{(const bf16_t*)(ws + WS_MERGED), (const bf16_t*)(ws + WS_WOUT), MT, DM, DM, DM, (const bf16_t*)(ws + WS_MRGS) - (size_t)MP * DM};
    pg8::TailOrder S; S.init(DM, DM, gridDim.x, obid(), 4); EpiOutF32 E{ap->out, (float*)(ws + WS_PART)}; pg8::gemm_phase(lds, g, S, E);
    { const int bid = obid(), nb = gridDim.x;
      if (bid >= 32) { __syncthreads(); xpose_convert((LAS float*)lds, ap->in[24], 2 * FFH, DM, 2 * FFH, (bf16_t*)(ws + WS_WF1), ap->in[23], 2, bid - 32, nb - 32); } }
}
__device__ __forceinline__ void phase7(LAS unsigned char* lds) {
    KA ap = kargs(); unsigned char* ws = ap->ws; const int bid = obid(), nb = gridDim.x;
    const int tid = otid(), lane = tid & 63, wid = tid >> 6;
    const float* part = (const float*)(ws + WS_PART); const float* gpm = ap->in[22]; float* hbuf = ap->out; bf16_t* hb = (bf16_t*)(ws + WS_HB); float* rh = (float*)(ws + WS_RH);
    const float* x0 = ap->in[0]; const float* x1 = ap->in[1];
    f32x4 gv[4];
#pragma unroll
    for (int i = 0; i < 4; ++i) gv[i] = *(const f32x4*)(gpm + i * 256 + lane * 4);
    const int stride = nb * 8;
    for (int rowb = bid * 8 + wid; rowb < MT; rowb += 2 * stride) {
        f32x4 mv[2][4], xv[2][4]; float sm[2];
#pragma unroll
        for (int u = 0; u < 2; ++u) { const int row = rowb + u * stride; sm[u] = 0.f;
            if (row < MT) { const float* xr = row < MP ? x0 + (size_t)row * DM : x1 + (size_t)(row - MP) * DM;
#pragma unroll
                for (int i = 0; i < 4; ++i) { const int k = i * 256 + lane * 4; xv[u][i] = __builtin_nontemporal_load((const f32x4*)(xr + k));
                    if (row < MP) mv[u][i] = __builtin_nontemporal_load((const f32x4*)(hbuf + (size_t)row * DM + k));
                    else { mv[u][i] = *(const f32x4*)(part + (size_t)(row - MP) * DM + k);
#pragma unroll
                        for (int sp = 1; sp < 4; ++sp) mv[u][i] += *(const f32x4*)(part + ((size_t)sp * MS + (row - MP)) * DM + k); } } } }
#pragma unroll
        for (int u = 0; u < 2; ++u) { const int row = rowb + u * stride;
            if (row < MT) {
#pragma unroll
                for (int i = 0; i < 4; ++i) sm[u] += mv[u][i][0] * mv[u][i][0] + mv[u][i][1] * mv[u][i][1] + mv[u][i][2] * mv[u][i][2] + mv[u][i][3] * mv[u][i][3];
                const float r = rsqrtf(wave_sum(sm[u]) * (1.f / DM) + EPSF); float ss = 0.f;
#pragma unroll
                for (int i = 0; i < 4; ++i) { const int k = i * 256 + lane * 4;
                    const f32x4 hv = xv[u][i] + mv[u][i] * gv[i] * r; ss += hv[0] * hv[0] + hv[1] * hv[1] + hv[2] * hv[2] + hv[3] * hv[3];
                    __builtin_nontemporal_store(hv, (f32x4*)(hbuf + (size_t)row * DM + k)); u32x2 w; w.x = pk2(hv[0], hv[1]); w.y = pk2(hv[2], hv[3]); *(u32x2*)(hb + (size_t)row * DM + k) = w; }
                ss = wave_sum(ss); if (lane == 0) rh[row] = rsqrtf(ss * (1.f / DM) + EPSF); } }
    }
}
__device__ __forceinline__ void phase8(LAS unsigned char* lds) {
    KA ap = kargs(); unsigned char* ws = ap->ws;
    pg8::Gemm g{(const bf16_t*)(ws + WS_HB), (const bf16_t*)(ws + WS_WF1), MT, 2 * FFH, DM, DM, nullptr}; pg8::StaticOrder S; S.init(MT, 2 * FFH, gridDim.x, obid()); EpiSwiGLU E{(bf16_t*)(ws + WS_ACT), (const float*)(ws + WS_RH)}; pg8::gemm_phase(lds, g, S, E);
    { const int nb = gridDim.x, nun = (MT / 256) * (2 * FFH / 256), rem = nun % nb, bid = obid();
      if (rem > 0 && bid >= rem) { __syncthreads(); xpose_convert((LAS float*)lds, ap->in[25], DM, FFH, DM, (bf16_t*)(ws + WS_WF2), nullptr, 0, bid - rem, nb - rem); }
      else if (rem == 0) { __syncthreads(); xpose_convert((LAS float*)lds, ap->in[25], DM, FFH, DM, (bf16_t*)(ws + WS_WF2), nullptr, 0, bid, nb); } }
}
__device__ __forceinline__ void phase9(LAS unsigned char* lds) {
    KA ap = kargs(); unsigned char* ws = ap->ws;
    pg8::Gemm g{(const bf16_t*)(ws + WS_ACT), (const bf16_t*)(ws + WS_WF2), MT, DM, FFH, FFH, (const bf16_t*)(ws + WS_ACT)};
    pg8::TailOrder S; S.init(DM, FFH, gridDim.x, obid(), 11); EpiOutF32 E{(float*)(ws + WS_FF), (float*)(ws + WS_PART)}; pg8::gemm_phase(lds, g, S, E);
}
__device__ __forceinline__ void phase10(LAS unsigned char* lds) {
    KA ap = kargs(); unsigned char* ws = ap->ws; const int bid = obid(), nb = gridDim.x;
    const int tid = otid(), lane = tid & 63, wid = tid >> 6;
    const float* part = (const float*)(ws + WS_PART); const float* gpf = ap->in[26]; float* hbuf = ap->out; const float* ff = (const float*)(ws + WS_FF);
    f32x4 gv[4];
#pragma unroll
    for (int i = 0; i < 4; ++i) gv[i] = *(const f32x4*)(gpf + i * 256 + lane * 4);
    const int stride = nb * 8;
    for (int rowb = bid * 8 + wid; rowb < MT; rowb += 2 * stride) {
        f32x4 fv[2][4], hv[2][4];
#pragma unroll
        for (int u = 0; u < 2; ++u) { const int row = rowb + u * stride;
            if (row < MT) {
#pragma unroll
                for (int i = 0; i < 4; ++i) { const int k = i * 256 + lane * 4; hv[u][i] = __builtin_nontemporal_load((const f32x4*)(hbuf + (size_t)row * DM + k));
                    if (row < MP) fv[u][i] = __builtin_nontemporal_load((const f32x4*)(ff + (size_t)row * DM + k));
                    else { fv[u][i] = *(const f32x4*)(part + (size_t)(row - MP) * DM + k);
#pragma unroll
                        for (int sp = 1; sp < 11; ++sp) fv[u][i] += *(const f32x4*)(part + ((size_t)sp * MS + (row - MP)) * DM + k); } } } }
#pragma unroll
        for (int u = 0; u < 2; ++u) { const int row = rowb + u * stride;
            if (row < MT) { float sm = 0.f;
#pragma unroll
                for (int i = 0; i < 4; ++i) sm += fv[u][i][0] * fv[u][i][0] + fv[u][i][1] * fv[u][i][1] + fv[u][i][2] * fv[u][i][2] + fv[u][i][3] * fv[u][i][3];
                const float r = rsqrtf(wave_sum(sm) * (1.f / DM) + EPSF);
#pragma unroll
                for (int i = 0; i < 4; ++i) { const int k = i * 256 + lane * 4; __builtin_nontemporal_store(hv[u][i] + fv[u][i] * gv[i] * r, (f32x4*)(hbuf + (size_t)row * DM + k)); } } }
    }
}

__global__ void __launch_bounds__(512) fwd_kernel(Args a) {
    extern __shared__ __attribute__((aligned(16))) unsigned char smem_raw[];
    LAS unsigned char* lds = (LAS unsigned char*)smem_raw;
    cg::grid_group grid = cg::this_grid();
    const int ph_lo = kargs()->ph_lo, ph_hi = kargs()->ph_hi;
    volatile LAS unsigned* bst = (volatile LAS unsigned*)(lds + LDS_BYTES - 16);
    if (threadIdx.x == 0) { bst[0] = 0u; bst[1] = 0u; }
    __syncthreads();
    const XcdBarrier xb = xcd_barrier_post((unsigned*)(kargs()->ws + WS_BAR), bst);
    if (ph_hi > 1000) grid.sync();
#define PHASE(k, call) if (ph_lo <= (k) && (k) < ph_hi) { if ((k) > ph_lo) xcd_barrier(xb); call; __syncthreads(); if (PROBE_MASK & (1 << (k))) { call; __syncthreads(); } }
    PHASE(0, phase0(lds))
    PHASE(1, phase1(lds))
    PHASE(2, phase2(lds))
    PHASE(3, phase3(lds))
    PHASE(4, phase4(lds))
    PHASE(5, phase5(lds))
    PHASE(6, phase6(lds))
    PHASE(7, phase7(lds))
    PHASE(8, phase8(lds))
    PHASE(9, phase9(lds))
    PHASE(10, phase10(lds))
#undef PHASE
}

extern "C" void kernel_launch(void* const* d_in, const int* in_sizes, int n_in, void* d_out, int out_size, void* d_ws, size_t ws_size, hipStream_t stream) {
    static int grid = 0;
    if (grid == 0) {
        int dev = 0, cus = 0, per_cu = 0;
        hipGetDevice(&dev);
        hipDeviceGetAttribute(&cus, hipDeviceAttributeMultiprocessorCount, dev);
        if (hipFuncSetAttribute((const void*)fwd_kernel, hipFuncAttributeMaxDynamicSharedMemorySize, LDS_BYTES) != hipSuccess) fprintf(stderr, "hipFuncSetAttribute failed\n");
        hipOccupancyMaxActiveBlocksPerMultiprocessor(&per_cu, (const void*)fwd_kernel, 512, LDS_BYTES);
        if (per_cu < 1) { fprintf(stderr, "occupancy query says %d\n", per_cu); per_cu = 1; }
        grid = cus * 1;
        if (ws_size < WS_END) fprintf(stderr, "workspace too small: %zu < %zu\n", ws_size, (size_t)WS_END);
        if (grid < 64) fprintf(stderr, "grid too small: %d\n", grid);
    }
    hipMemsetAsync((unsigned char*)d_ws + WS_BAR, 0, 16384, stream);
    Args a{};
    for (int i = 0; i < 27; ++i) a.in[i] = (const float*)d_in[i];
    a.out = (float*)d_out; a.ws = (unsigned char*)d_ws; a.ph_lo = 0; a.ph_hi = 12;
    void* args[] = {&a};
    hipError_t e = hipLaunchCooperativeKernel((const void*)fwd_kernel, dim3(grid), dim3(512), args, LDS_BYTES, stream);
    if (e != hipSuccess) fprintf(stderr, "cooperative launch failed: %s (grid %d)\n", hipGetErrorString(e), grid);
}
```

```cpp
#include <hip/hip_runtime.h>
#include <hip/hip_cooperative_groups.h>
#include <cstdio>
#include <cstdint>
namespace cg = cooperative_groups;

#define LAS __attribute__((address_space(3)))
typedef unsigned short bf16_t;
typedef short bf16x8 __attribute__((ext_vector_type(8)));
typedef short bf16x4 __attribute__((ext_vector_type(4)));
typedef float f32x4 __attribute__((ext_vector_type(4)));
typedef float f32x2 __attribute__((ext_vector_type(2)));
typedef unsigned u32x4 __attribute__((ext_vector_type(4)));
typedef unsigned u32x2 __attribute__((ext_vector_type(2)));

constexpr int DM = 1024, MP = 16384, MS = 512, MT = MP + MS, TSEQ = 2048, NB = 8, NBS = 128;
constexpr int NPROJ = 7680, FFH = 2816, INW = 7688;
constexpr int C_HQ = 0, C_HF = 512, C_HI = 1024, C_HG = 1536, C_GQKV = 2048, C_GZ = 3584, C_MQ = 4096, C_GATE = 4608;
constexpr float EPSF = 1e-6f;
constexpr int LDS_BYTES = 147456;
#ifndef PROBE_DRY
#define PROBE_DRY 0
#endif
#ifndef PROBE_MASK
#define PROBE_MASK 0
#endif

constexpr size_t al256(size_t x) { return (x + 255) & ~(size_t)255; }
constexpr size_t WS_WIN = 0;
constexpr size_t WS_WKV = WS_WIN + (size_t)NPROJ * DM * 2;
constexpr size_t WS_WBR = WS_WKV + (size_t)DM * DM * 2;
constexpr size_t WS_WOUT = WS_WBR + (size_t)3 * DM * 512 * 2;
constexpr size_t WS_RX = WS_WOUT + (size_t)DM * DM * 2;
constexpr size_t WS_RMEM = WS_RX + al256((size_t)MT * 4);
constexpr size_t WS_AB = WS_RMEM + al256(2048 * 4);
constexpr size_t WS_DEC = WS_AB + al256((size_t)MT * 8 * 4);
constexpr size_t WS_GCS = WS_DEC + (size_t)1024 * 128 * 4;
constexpr size_t WS_PSS = WS_GCS + al256(1024 * 4);
constexpr size_t WS_RH = WS_PSS + (size_t)MT * 16 * 4;
constexpr size_t WS_MEMB = WS_RH + al256((size_t)MT * 4);
constexpr size_t WS_MEMK = WS_MEMB + (size_t)2048 * 1024 * 2;
constexpr size_t WS_MEMV = WS_MEMK + (size_t)2048 * 512 * 2;
constexpr size_t WS_PROJ = WS_MEMV + (size_t)2048 * 512 * 2;
constexpr size_t WS_G2 = WS_PROJ + (size_t)MT * NPROJ * 2;
constexpr size_t WS_KGT = WS_G2, WS_QG = WS_G2 + 16777216, WS_AQK = WS_G2 + 2 * 16777216;
constexpr size_t WS_MERGED = WS_G2;
constexpr size_t WS_BAR = WS_G2 + 41943040;
constexpr size_t WS_WF1 = WS_BAR + 16384;
constexpr size_t WS_WF2 = WS_WF1 + (size_t)2 * FFH * DM * 2;
constexpr size_t WS_MRGS = WS_WF2 + (size_t)DM * FFH * 2;
constexpr size_t WS_END = WS_MRGS + (size_t)MS * DM * 2;
constexpr size_t WS_HB = WS_PROJ;
constexpr size_t WS_ACT = WS_HB + (size_t)MT * DM * 2;
constexpr size_t WS_FF = WS_ACT + (size_t)MT * FFH * 2;
constexpr size_t WS_PART = WS_FF + (size_t)MT * DM * 4;
static_assert(WS_PART + (size_t)11 * MS * DM * 4 <= WS_G2, "late buffers overflow proj area");
static_assert(WS_END <= 362000000, "workspace too large");
constexpr size_t O_Y = 0, O_MK = 17301504, O_MV = 18350080, O_HGP = 19398656, O_GDP = 19922944, O_CVP = 20447232,
                 O_HGS = 20484096, O_GDS = 28872704, O_CVS = 37261312;
constexpr size_t OB_DS = 0, OB_UT = 33554432, OB_W = OB_UT + 16777216;
constexpr size_t OB_XB = O_HGS * 4;

struct Args {
    const float* in[27];
    float* out;
    unsigned char* ws;
    int ph_lo, ph_hi;
};
typedef const Args __attribute__((address_space(4)))* KA;
__device__ __forceinline__ int otid() { int t = threadIdx.x; asm volatile("" : "+v"(t)); return t; }
__device__ __forceinline__ int obid() { int t = blockIdx.x; asm volatile("" : "+s"(t)); return t; }
__device__ __forceinline__ KA kargs() { KA p = (KA)__builtin_amdgcn_kernarg_segment_ptr(); asm volatile("" : "+s"(p)); return p; }

__device__ __forceinline__ float bf2f(bf16_t b) { return __uint_as_float(((unsigned)b) << 16); }
__device__ __forceinline__ bf16_t f2bf(float f) { unsigned u = __float_as_uint(f); u += 0x7FFFu + ((u >> 16) & 1u); return (bf16_t)(u >> 16); }
__device__ __forceinline__ unsigned pk2(float lo, float hi) { return (unsigned)f2bf(lo) | ((unsigned)f2bf(hi) << 16); }
template <int CTRL> __device__ __forceinline__ float dppf(float v) { return __int_as_float(__builtin_amdgcn_update_dpp(0, __float_as_int(v), CTRL, 0xf, 0xf, true)); }
__device__ __forceinline__ float wave_sum(float v) {
    v += dppf<0xB1>(v);
    v += dppf<0x4E>(v);
    v += dppf<0x141>(v);
    v += dppf<0x140>(v);
    const int vi = __float_as_int(v);
    return (__int_as_float(__builtin_amdgcn_readlane(vi, 0)) + __int_as_float(__builtin_amdgcn_readlane(vi, 16))) + (__int_as_float(__builtin_amdgcn_readlane(vi, 32)) + __int_as_float(__builtin_amdgcn_readlane(vi, 48)));
}
__device__ __forceinline__ float sigmoidf_(float x) { return __builtin_amdgcn_rcpf(1.0f + __expf(-x)); }
__device__ __forceinline__ float siluf_(float x) { return x * __builtin_amdgcn_rcpf(1.0f + __expf(-x)); }
__device__ __forceinline__ f32x4 mfma16(bf16x8 a, bf16x8 b, f32x4 c) { return __builtin_amdgcn_mfma_f32_16x16x32_bf16(a, b, c, 0, 0, 0); }


#define XB_TMO      128
#define XB_XCNT(j)  (256  + 64 * (j))
#define XB_XSUB(j)  (1280 + 64 * (j))
#define XB_XGEN(j)  (2304 + 64 * (j))
#define XB_TOP      3328
#define XB_TOPGEN   3392
#define XCD_BAR_WORDS 3456
#define XB_SPIN_CAP (1u << 18)
__device__ __forceinline__ unsigned xb_ld(unsigned* p)              { return __hip_atomic_load(p, __ATOMIC_RELAXED, __HIP_MEMORY_SCOPE_AGENT); }
__device__ __forceinline__ unsigned xb_add(unsigned* p, unsigned v) { return __hip_atomic_fetch_add(p, v, __ATOMIC_RELAXED, __HIP_MEMORY_SCOPE_AGENT); }
__device__ __forceinline__ unsigned xb_xcc_id() { return (unsigned)__builtin_amdgcn_s_getreg((3 << 11) | 20) & 0xFu; }
#define XB_SPIN(cond, bar) do { unsigned _sp = 0; while (cond) {   \
    if ((++_sp & 255u) == 0u) { if (xb_ld(&(bar)[XB_TMO])) break; if (_sp > XB_SPIN_CAP) { atomicAdd(&(bar)[XB_TMO], 1u); break; } } } } while (0)
struct XcdBarrier { unsigned* bar; unsigned x; volatile LAS unsigned* st; };
__device__ __forceinline__ XcdBarrier xcd_barrier_post(unsigned* bar, volatile LAS unsigned* st) {
    XcdBarrier b; b.bar = bar; b.x = xb_xcc_id(); b.st = st;
    if (threadIdx.x == 0) (void)xb_add(&bar[XB_XCNT(b.x)], 1u);
    return b;
}
__device__ __forceinline__ void xcd_barrier_complete(unsigned* bar, unsigned x, unsigned& nloc, unsigned& nx) {
    const unsigned G = gridDim.x * gridDim.y * gridDim.z;
    unsigned sum, cnt, mine, sp = 0u;
    for (;;) {
        sum = 0u; cnt = 0u; mine = 0u;
#pragma unroll
        for (unsigned j = 0; j < 16; ++j) { const unsigned c = xb_ld(&bar[XB_XCNT(j)]); sum += c; cnt += (c > 0u) ? 1u : 0u; mine = (j == x) ? c : mine; }
        if (sum == G) break;
        __builtin_amdgcn_s_sleep(1);
        if ((++sp & 255u) == 0u) { if (xb_ld(&bar[XB_TMO])) break; if (sp > XB_SPIN_CAP) { atomicAdd(&bar[XB_TMO], 1u); break; } }
    }
    nloc = mine > 0u ? mine : 1u; nx = cnt > 0u ? cnt : 1u;
}
__device__ __forceinline__ void xcd_barrier(const XcdBarrier& b) {
    asm volatile("s_waitcnt vmcnt(0)" ::: "memory");
    __syncthreads();
    if (threadIdx.x == 0) {
        unsigned* bar = b.bar;
        __builtin_amdgcn_s_waitcnt(0);
        unsigned nloc = b.st[0], nx = b.st[1];
        if (nloc == 0u) { xcd_barrier_complete(bar, b.x, nloc, nx); b.st[0] = nloc; b.st[1] = nx; }
        const unsigned old = xb_add(&bar[XB_XSUB(b.x)], 1u);
        const unsigned gen = old / nloc;
        if (old + 1u == (gen + 1u) * nloc) {
            __builtin_amdgcn_fence(__ATOMIC_RELEASE, "agent");
            asm volatile("s_waitcnt vmcnt(0)" ::: "memory");
            const unsigned og = xb_add(&bar[XB_TOP], 1u);
            const unsigned tg = og / nx;
            if (og + 1u == (tg + 1u) * nx) xb_add(&bar[XB_TOPGEN], 1u);
            else XB_SPIN(xb_ld(&bar[XB_TOPGEN]) == tg, bar);
            __builtin_amdgcn_fence(__ATOMIC_ACQUIRE, "agent");
            xb_add(&bar[XB_XGEN(b.x)], 1u);
            asm volatile("s_waitcnt vmcnt(0)" ::: "memory");
        } else {
            XB_SPIN(xb_ld(&bar[XB_XGEN(b.x)]) == gen, bar);
            __builtin_amdgcn_fence(__ATOMIC_ACQUIRE, "agent");
            asm volatile("s_waitcnt vmcnt(0)" ::: "memory");
        }
    }
    __syncthreads();
}

namespace pg8 {
constexpr int BM = 256, BK = 64, HALF = 128, HTB = HALF * BK * 2, STAGE_BYTES = 8 * HTB, NXCD = 8, WGM = 8;
__host__ __device__ __forceinline__ int lds_byte(int r, int c) { const int st = (r >> 4) * 2 + (c >> 5), rr = r & 15, cc = c & 31, ob = rr * 64 + cc * 2; return st * 1024 + (ob ^ (((ob >> 9) & 1) << 5)); }
__host__ __device__ __forceinline__ void stage_rc(int b, int& R, int& C) { const int st = b / 1024, sb = b % 1024, swz = sb ^ (((sb >> 9) & 1) << 5); R = (st >> 1) * 16 + swz / 64; C = (st & 1) * 32 + (swz % 64) / 2; }
__host__ __device__ __forceinline__ int perm32(int rho) { const int n = rho >> 4, i = rho & 15; return 8 * (i >> 2) + 4 * n + (i & 3); }
struct Unit { int pm, pn, koff, nt, tag; };
struct Gemm { const bf16_t* A; const bf16_t* Bt; int M, N, K, lda; const bf16_t* A2; };
struct StaticOrder {
    int nM, nN, nwg, G, c;
    __device__ void init(int M, int N, int G_, int c_, int K = 1024) { nM = M / BM; nN = N / BM; nwg = nM * nN; G = G_; c = c_; ntk = K / BK; }
    __device__ bool next(int i, Unit& u) const {
        const long L = (long)i * G + c; if (L >= nwg) return false;
        int wgid = (int)L; { const int q = nwg / NXCD, r = nwg % NXCD, xcd = wgid % NXCD, off = wgid / NXCD; wgid = (xcd < r ? xcd * (q + 1) : r * (q + 1) + (xcd - r) * q) + off; }
        const int nig = WGM * nN, gid = wgid / nig, fm = gid * WGM, gsz = (nM - fm) < WGM ? (nM - fm) : WGM;
        u.pm = fm + ((wgid % nig) % gsz); u.pn = (wgid % nig) / gsz; u.koff = 0; u.nt = ntk; u.tag = 0; return true;
    }
    int ntk;
};
struct TailOrder {
    StaticOrder base; int nsplit, njobs;
    __device__ void init(int N, int K, int G_, int c_, int nsplit_) { base.init(MP, N, G_, c_, K); nsplit = nsplit_; njobs = 8 * nsplit_; }
    __device__ bool next(int i, Unit& u) const {
        const int np = (base.nwg - base.c + base.G - 1) / base.G;
        if (i < np) return base.next(i, u);
        const int L = (i - np) * base.G + base.c; if (L >= njobs) return false;
        const int ks = L % nsplit, un = L / nsplit; u.pm = 64 + (un >> 2); u.pn = un & 3; u.koff = ks * 256; u.nt = 4; u.tag = 1 + ks; return true;
    }
};
struct SampleOrder {
    int G, c, ntk;
    __device__ void init(int K, int G_, int c_) { G = G_; c = c_; ntk = K / BK; }
    __device__ bool next(int i, Unit& u) const { const int L = i * G + c; if (L >= 8) return false; u.pm = 64 + (L >> 2); u.pn = L & 3; u.koff = 0; u.nt = ntk; u.tag = 0; return true; }
};
__device__ __forceinline__ unsigned cvt_pk_bf16(float lo, float hi) { unsigned r; asm volatile("v_cvt_pk_bf16_f32 %0, %1, %2" : "=v"(r) : "v"(lo), "v"(hi)); return r; }

template <class Epi, class Sched>
__device__ __forceinline__ void gemm_phase(LAS unsigned char* lds, const Gemm g, const Sched& S, const Epi& E) {
    int tid_ = threadIdx.x; asm volatile("" : "+v"(tid_));
    const int tid = tid_, wid = __builtin_amdgcn_readfirstlane(tid >> 6), lane = tid & 63, wr = wid >> 2, wc = wid & 3, fr = lane & 15, fq = lane >> 4;
    const int K = g.K, lda = g.lda;
    unsigned voffA[2], voffB[2];
#pragma unroll
    for (int i = 0; i < 2; ++i) { int R, C; stage_rc(tid * 16 + i * 8192, R, C); const int Rb = Epi::PERM ? ((R & ~31) + perm32(R & 31)) : R;
        voffA[i] = (unsigned)(R * lda + C) * 2u; voffB[i] = (unsigned)(Rb * K + C) * 2u; }
    const size_t kstep = (size_t)(BK * 2);
    const size_t hstepA = (size_t)HALF * lda * 2, hstepB = (size_t)HALF * K * 2;
    const size_t tstepA = 2 * hstepA, tstepB = 2 * hstepB;
    const unsigned ldsw = (unsigned)wid * 1024u;
    const int aoff = lds_byte(wr * 64 + fr, fq * 8), boff = lds_byte(wc * 32 + fr, fq * 8);
#define PG8_SA(b, h) (((b) * 2 + (h)) * HTB)
#define PG8_SB(b, h) ((4 + (b) * 2 + (h)) * HTB)
#define PG8_STAGE(bufoff, gbase, voff) do { _Pragma("unroll") for (int _i = 0; _i < 2; ++_i) \
        __builtin_amdgcn_global_load_lds((const unsigned*)((const char*)(gbase) + (voff)[_i]), (LAS unsigned*)(lds + (bufoff) + ldsw + _i * 8192), 16, 0, 0); } while (0)
#define PG8_LDA(dst, b, h) do { _Pragma("unroll") for (int m = 0; m < 4; ++m) _Pragma("unroll") for (int k = 0; k < 2; ++k) dst[m][k] = *(const LAS bf16x8*)(lds + PG8_SA(b, h) + aoff + m * 2048 + k * 1024); } while (0)
#define PG8_LDB(dst, b, h) do { _Pragma("unroll") for (int n = 0; n < 2; ++n) _Pragma("unroll") for (int k = 0; k < 2; ++k) dst[n][k] = *(const LAS bf16x8*)(lds + PG8_SB(b, h) + boff + n * 2048 + k * 1024); } while (0)
#define PG8_MMA(ai, bj, At, Bt) do { __builtin_amdgcn_s_setprio(1); _Pragma("unroll") for (int m = 0; m < 4; ++m) _Pragma("unroll") for (int n = 0; n < 2; ++n) _Pragma("unroll") for (int k = 0; k < 2; ++k) \
        acc[ai][bj][m][n] = __builtin_amdgcn_mfma_f32_16x16x32_bf16(Bt[n][k], At[m][k], acc[ai][bj][m][n], 0, 0, 0); __builtin_amdgcn_s_setprio(0); } while (0)
#define PG8_WAIT_V(n) asm volatile("s_waitcnt vmcnt(" #n ")" ::: "memory")
#define PG8_WAIT_L(n) asm volatile("s_waitcnt lgkmcnt(" #n ")" ::: "memory")
#define PG8_BAR __builtin_amdgcn_s_barrier()
#define PG8_SCHED __builtin_amdgcn_sched_barrier(0)
    Unit cur, nxt; int ui = 0;
    if (!S.next(0, cur)) return;
    f32x4 acc[2][2][4][2];
#pragma unroll
    for (int a = 0; a < 2; ++a)
#pragma unroll
        for (int b = 0; b < 2; ++b)
#pragma unroll
            for (int m = 0; m < 4; ++m)
#pragma unroll
                for (int n = 0; n < 2; ++n) acc[a][b][m][n] = (f32x4){0.f, 0.f, 0.f, 0.f};
    bf16x8 At[4][2], B0[2][2], B1[2][2];
    const char* cA = (const char*)(cur.tag ? g.A2 : g.A) + (size_t)cur.pm * tstepA + (size_t)cur.koff * 2; const char* cB = (const char*)g.Bt + (size_t)cur.pn * tstepB + (size_t)cur.koff * 2;
    PG8_STAGE(PG8_SB(0, 0), cB, voffB); PG8_STAGE(PG8_SB(0, 1), cB + hstepB, voffB); PG8_STAGE(PG8_SA(0, 0), cA, voffA); PG8_STAGE(PG8_SA(0, 1), cA + hstepA, voffA);
    if (wr == 1) PG8_BAR;
    PG8_WAIT_V(2); PG8_BAR;
    PG8_STAGE(PG8_SB(1, 0), cB + kstep, voffB); PG8_STAGE(PG8_SA(1, 0), cA + kstep, voffA); PG8_STAGE(PG8_SB(1, 1), cB + hstepB + kstep, voffB);
    PG8_WAIT_V(6); PG8_BAR;
    for (;;) {
        const bool has_next = S.next(ui + 1, nxt);
        const char* nA = has_next ? (const char*)(nxt.tag ? g.A2 : g.A) + (size_t)nxt.pm * tstepA + (size_t)nxt.koff * 2 : cA; const char* nB = has_next ? (const char*)g.Bt + (size_t)nxt.pn * tstepB + (size_t)nxt.koff * 2 : cB;
        const int nt = cur.nt;
        for (int t = 0; t < nt; t += 2) {
            const bool last = (t == nt - 2);
            const char* a1 = cA + (size_t)(t + 1) * kstep;
            const char* a2 = last ? nA : cA + (size_t)(t + 2) * kstep; const char* b2 = last ? nB : cB + (size_t)(t + 2) * kstep;
            const char* a3 = a2 + kstep; const char* b3 = b2 + kstep;
            PG8_LDB(B0, 0, 0); PG8_LDB(B1, 0, 1); PG8_SCHED; PG8_LDA(At, 0, 0); PG8_STAGE(PG8_SA(1, 1), a1 + hstepA, voffA);
            PG8_WAIT_V(8); PG8_WAIT_L(0); PG8_BAR; PG8_MMA(0, 0, At, B0); PG8_MMA(0, 1, At, B1); PG8_BAR; PG8_SCHED;
            PG8_LDA(At, 0, 1); PG8_STAGE(PG8_SB(0, 0), b2, voffB); PG8_STAGE(PG8_SB(0, 1), b2 + hstepB, voffB); PG8_STAGE(PG8_SA(0, 0), a2, voffA);
            PG8_WAIT_V(8); PG8_WAIT_L(0); PG8_BAR; PG8_MMA(1, 0, At, B0); PG8_MMA(1, 1, At, B1); PG8_BAR; PG8_SCHED;
            PG8_LDB(B0, 1, 0); PG8_LDB(B1, 1, 1); PG8_SCHED; PG8_LDA(At, 1, 0); PG8_STAGE(PG8_SA(0, 1), a2 + hstepA, voffA);
            PG8_WAIT_V(8); PG8_WAIT_L(0); PG8_BAR; PG8_MMA(0, 0, At, B0); PG8_MMA(0, 1, At, B1); PG8_BAR; PG8_SCHED;
            PG8_LDA(At, 1, 1); PG8_STAGE(PG8_SB(1, 0), b3, voffB); PG8_STAGE(PG8_SB(1, 1), b3 + hstepB, voffB); PG8_STAGE(PG8_SA(1, 0), a3, voffA);
            PG8_WAIT_V(8); PG8_WAIT_L(0); PG8_BAR; PG8_MMA(1, 0, At, B0); PG8_MMA(1, 1, At, B1); PG8_BAR; PG8_SCHED;
        }
        if (wr == 0) PG8_BAR;
        E(acc, cur, wr, wc, fr, fq);
        if (!has_next) break;
#pragma unroll
        for (int a = 0; a < 2; ++a)
#pragma unroll
            for (int b = 0; b < 2; ++b)
#pragma unroll
                for (int m = 0; m < 4; ++m)
#pragma unroll
                    for (int n = 0; n < 2; ++n) acc[a][b][m][n] = (f32x4){0.f, 0.f, 0.f, 0.f};
        cur = nxt; cA = nA; cB = nB; ++ui;
        if (wr == 1) PG8_BAR;
    }
    PG8_WAIT_V(0);
    PG8_BAR;
#undef PG8_SA
#undef PG8_SB
#undef PG8_STAGE
#undef PG8_LDA
#undef PG8_LDB
#undef PG8_MMA
#undef PG8_WAIT_V
#undef PG8_WAIT_L
#undef PG8_BAR
#undef PG8_SCHED
}
}
using pg8::Unit;

struct EpiProj {
    static constexpr bool PERM = true;
    bf16_t* O; const float* rs;
    __device__ __forceinline__ void operator()(const f32x4 (&acc)[2][2][4][2], const Unit& u, int wr, int wc, int fr, int fq) const {
        const int row0 = u.pm * 256 + wr * 64 + fr, col0 = u.pn * 256 + wc * 32 + 8 * fq;
#pragma unroll
        for (int ai = 0; ai < 2; ++ai)
#pragma unroll
            for (int m = 0; m < 4; ++m) { const int row = row0 + ai * 128 + m * 16; const float r = rs[row]; bf16_t* rowp = O + (size_t)row * NPROJ + col0;
#pragma unroll
                for (int bj = 0; bj < 2; ++bj) { const f32x4 v0 = acc[ai][bj][m][0] * r, v1 = acc[ai][bj][m][1] * r;
                    u32x4 w; w.x = pg8::cvt_pk_bf16(v0[0], v0[1]); w.y = pg8::cvt_pk_bf16(v0[2], v0[3]); w.z = pg8::cvt_pk_bf16(v1[0], v1[1]); w.w = pg8::cvt_pk_bf16(v1[2], v1[3]);
                    *(u32x4*)(rowp + bj * 128) = w; } }
    }
};
struct EpiKV {
    static constexpr bool PERM = false;
    float* ok; float* ov; bf16_t* bk; bf16_t* bv; const float* rs;
    __device__ __forceinline__ void operator()(const f32x4 (&acc)[2][2][4][2], const Unit& u, int wr, int wc, int fr, int fq) const {
        const int row0 = u.pm * 256 + wr * 64 + fr; const int isv = u.pn >> 1; const int colt = (u.pn & 1) * 256 + wc * 32 + 4 * fq;
        float* of = isv ? ov : ok; bf16_t* ob = isv ? bv : bk;
#pragma unroll
        for (int ai = 0; ai < 2; ++ai)
#pragma unroll
            for (int m = 0; m < 4; ++m) { const int row = row0 + ai * 128 + m * 16; const float r = rs[row];
#pragma unroll
                for (int bj = 0; bj < 2; ++bj)
#pragma unroll
                    for (int n = 0; n < 2; ++n) { const f32x4 v = acc[ai][bj][m][n] * r; const int col = colt + bj * 128 + n * 16;
                        *(f32x4*)(of + (size_t)row * 512 + col) = v;
                        u32x2 w; w.x = pg8::cvt_pk_bf16(v[0], v[1]); w.y = pg8::cvt_pk_bf16(v[2], v[3]); *(u32x2*)(ob + (size_t)row * 512 + col) = w; } }
    }
};

__device__ __forceinline__ void xpose_convert(LAS float* tile, const float* __restrict__ src, int ldsrc, int K, int N, bf16_t* __restrict__ dst, const float* __restrict__ scale, int mode, int bid, int nb) {
    const int tid = otid(); const int nkt = K / 64, ntile = nkt * (N / 64);
    float cur[8];
    auto tile_src = [&](int t, int& k0, int& n0) -> int { const int kt = t % nkt, nti = t / nkt; k0 = kt * 64; n0 = nti * 64; int sc0 = n0;
        if (mode == 1) sc0 = n0 < 4096 ? n0 : n0 + 8;
        else if (mode == 2) { const int pn = n0 >> 8, bj = (n0 >> 7) & 1, i = n0 & 127; sc0 = bj * FFH + pn * 128 + i; }
        return sc0; };
    auto load_tile = [&](int t, float (&v)[8]) { int k0, n0; const int sc0 = tile_src(t, k0, n0);
#pragma unroll
        for (int i = 0; i < 8; ++i) { const int idx = tid + i * 512, r = idx >> 6, c = idx & 63; float x = src[(size_t)(k0 + r) * ldsrc + sc0 + c]; if (scale) x *= scale[k0 + r]; v[i] = x; } };
    int t = bid;
    if (t < ntile) load_tile(t, cur);
    for (; t < ntile; t += nb) {
        int k0, n0; (void)tile_src(t, k0, n0);
#pragma unroll
        for (int i = 0; i < 8; ++i) { const int idx = tid + i * 512, r = idx >> 6, c = idx & 63; tile[r * 65 + c] = cur[i]; }
        __syncthreads();
        if (t + nb < ntile) load_tile(t + nb, cur);
        { const int n = tid >> 3, kk = (tid & 7) * 8; u32x4 o;
          o.x = pk2(tile[(kk + 0) * 65 + n], tile[(kk + 1) * 65 + n]); o.y = pk2(tile[(kk + 2) * 65 + n], tile[(kk + 3) * 65 + n]);
          o.z = pk2(tile[(kk + 4) * 65 + n], tile[(kk + 5) * 65 + n]); o.w = pk2(tile[(kk + 6) * 65 + n], tile[(kk + 7) * 65 + n]);
          *(u32x4*)(dst + (size_t)(n0 + n) * K + k0 + kk) = o; }
        __syncthreads();
    }
}

__device__ __forceinline__ void phase0(LAS unsigned char* lds) {
    KA ap = kargs();
    struct { const float* in[27]; float* out; unsigned char* ws; } a; a.out = ap->out; a.ws = ap->ws;
    a.in[0] = ap->in[0]; a.in[1] = ap->in[1]; a.in[2] = ap->in[2]; a.in[9] = ap->in[9]; a.in[10] = ap->in[10]; a.in[16] = ap->in[16]; a.in[17] = ap->in[17]; a.in[18] = ap->in[18]; a.in[19] = ap->in[19]; a.in[20] = ap->in[20]; a.in[21] = ap->in[21];
    const int tid = otid(), lane = tid & 63, wid = tid >> 6, bid = obid(), nb = gridDim.x;
    unsigned char* ws = a.ws;
    LAS float* tile = (LAS float*)lds;
    xpose_convert(tile, a.in[10], INW, DM, NPROJ, (bf16_t*)(ws + WS_WIN), a.in[9], 1, bid, nb);
    xpose_convert(tile, a.in[17], DM, DM, DM, (bf16_t*)(ws + WS_WKV), a.in[16], 0, bid, nb);
    xpose_convert(tile, a.in[18], DM, 512, DM, (bf16_t*)(ws + WS_WBR), nullptr, 0, bid, nb);
    xpose_convert(tile, a.in[19], DM, 512, DM, (bf16_t*)(ws + WS_WBR) + (size_t)DM * 512, nullptr, 0, bid, nb);
    xpose_convert(tile, a.in[20], DM, 512, DM, (bf16_t*)(ws + WS_WBR) + (size_t)2 * DM * 512, nullptr, 0, bid, nb);
    xpose_convert(tile, a.in[21], DM, DM, DM, (bf16_t*)(ws + WS_WOUT), nullptr, 0, bid, nb);
    LAS float* wab = (LAS float*)lds;
    for (int i = tid; i < 8192; i += 512) { const int k = i >> 3, j = i & 7; wab[i] = a.in[9][k] * a.in[10][(size_t)k * INW + 4096 + j]; }
    __syncthreads();
    bf16_t* xb = (bf16_t*)((unsigned char*)a.out + OB_XB); bf16_t* memb = (bf16_t*)(ws + WS_MEMB);
    float* rx = (float*)(ws + WS_RX); float* rmem = (float*)(ws + WS_RMEM); float* ab = (float*)(ws + WS_AB);
    const int stride = nb * 8;
    for (int rowb = bid * 8 + wid; rowb < MT + 2048; rowb += 2 * stride) {
        f32x4 v[2][4];
#pragma unroll
        for (int u = 0; u < 2; ++u) { const int row = rowb + u * stride;
            if (row < MT + 2048) { const float* src = row < MP ? a.in[0] + (size_t)row * DM : (row < MT ? a.in[1] + (size_t)(row - MP) * DM : a.in[2] + (size_t)(row - MT) * DM);
#pragma unroll
                for (int i = 0; i < 4; ++i) v[u][i] = __builtin_nontemporal_load((const f32x4*)(src + i * 256 + lane * 4)); } }
#pragma unroll
        for (int u = 0; u < 2; ++u) { const int row = rowb + u * stride;
            if (row < MT + 2048) {
                bf16_t* dst = row < MT ? xb + (size_t)row * DM : memb + (size_t)(row - MT) * DM;
                float ss = 0.f; float dots[8];
#pragma unroll
                for (int j = 0; j < 8; ++j) dots[j] = 0.f;
#pragma unroll
                for (int i = 0; i < 4; ++i) { const int k = i * 256 + lane * 4; const f32x4 vv = v[u][i];
                    ss += vv[0] * vv[0] + vv[1] * vv[1] + vv[2] * vv[2] + vv[3] * vv[3];
                    u32x2 w; w.x = pk2(vv[0], vv[1]); w.y = pk2(vv[2], vv[3]); *(u32x2*)(dst + k) = w;
                    if (row < MT) {
#pragma unroll
                        for (int e = 0; e < 4; ++e) { const f32x4 w0 = *(const LAS f32x4*)(wab + (k + e) * 8), w1 = *(const LAS f32x4*)(wab + (k + e) * 8 + 4);
                            dots[0] += vv[e] * w0[0]; dots[1] += vv[e] * w0[1]; dots[2] += vv[e] * w0[2]; dots[3] += vv[e] * w0[3];
                            dots[4] += vv[e] * w1[0]; dots[5] += vv[e] * w1[1]; dots[6] += vv[e] * w1[2]; dots[7] += vv[e] * w1[3]; } } }
                ss = wave_sum(ss);
                const float r = rsqrtf(ss * (1.0f / DM) + EPSF);
                if (row < MT) {
#pragma unroll
                    for (int j = 0; j < 8; ++j) dots[j] = wave_sum(dots[j]);
                    if (lane == 0) { rx[row] = r;
#pragma unroll
                        for (int j = 0; j < 8; ++j) ab[(size_t)row * 8 + j] = dots[j] * r; }
                } else if (lane == 0) rmem[row - MT] = r; } }
    }
}

__device__ __forceinline__ void phase1(LAS unsigned char* lds) {
    KA ap = kargs();
    struct { float* out; unsigned char* ws; } a; a.out = ap->out; a.ws = ap->ws;
    unsigned char* ws = a.ws;
    { pg8::Gemm g{(const bf16_t*)((unsigned char*)a.out + OB_XB), (const bf16_t*)(ws + WS_WIN), MT, NPROJ, DM, DM, nullptr};
      pg8::StaticOrder S; S.init(MT, NPROJ, gridDim.x, obid());
      EpiProj E{(bf16_t*)(ws + WS_PROJ), (const float*)(ws + WS_RX)};
      pg8::gemm_phase(lds, g, S, E); }
    { pg8::Gemm g{(const bf16_t*)(ws + WS_MEMB), (const bf16_t*)(ws + WS_WKV), 2048, DM, DM, DM, nullptr};
      pg8::StaticOrder S; S.init(2048, DM, gridDim.x, gridDim.x - 1 - obid());
      EpiKV E{a.out + O_MK, a.out + O_MV, (bf16_t*)(ws + WS_MEMK), (bf16_t*)(ws + WS_MEMV), (const float*)(ws + WS_RMEM)};
      pg8::gemm_phase(lds, g, S, E); }
}

__device__ __forceinline__ float lb_of(const float* lbl, int ch) { return 1.0f / (1.0f + __expf(lbl[512 + ch] - lbl[ch])); }
__device__ __forceinline__ float softplusf_(float x) { return x > 20.f ? x : log1pf(__expf(x)); }
__device__ __forceinline__ bf16x8 ld2x4(const LAS bf16_t* p0, const LAS bf16_t* p1) {
    const bf16x4 a = *(const LAS bf16x4*)p0, b = *(const LAS bf16x4*)p1; bf16x8 r;
    r[0] = a[0]; r[1] = a[1]; r[2] = a[2]; r[3] = a[3]; r[4] = b[0]; r[5] = b[1]; r[6] = b[2]; r[7] = b[3]; return r;
}
__device__ __forceinline__ bf16x8 pkfrag(const f32x4 a, const f32x4 b) {
    u32x4 w; w.x = pk2(a[0], a[1]); w.y = pk2(a[2], a[3]); w.z = pk2(b[0], b[1]); w.w = pk2(b[2], b[3]); return *(bf16x8*)&w;
}

__device__ __forceinline__ void hg_pass1(LAS unsigned char* lds, int item, const bf16_t* proj, const float* lbl, bf16_t* dS, float* dec) {
    const int tid = otid(), lane = tid & 63, wid = tid >> 6, r = lane & 15, q = lane >> 4;
    const int d = tid & 127, seg = tid >> 7;
    const int c = item & 31, bh = item >> 5, h = bh & 3, b = bh >> 2;
    LAS bf16_t* KT = (LAS bf16_t*)lds;
    LAS bf16_t* VT = KT + 128 * 72;
    LAS float* tot = (LAS float*)(VT + 128 * 72);
    LAS bf16_t* SW = (LAS bf16_t*)(tot + 512) + wid * (16 * 136);
    const size_t row0 = (size_t)b * TSEQ + c * 64 + seg * 16;
    const bf16_t* pf = proj + row0 * NPROJ + C_HF + h * 128 + d;
    const bf16_t* pv = proj + row0 * NPROJ + C_HI + h * 128 + d;
    const float lb = lb_of(lbl, h * 128 + d);
    float Lc[16], kk[16]; float run = 0.f; unsigned vp[8];
#pragma unroll
    for (int i = 0; i < 16; ++i) { const float fz = bf2f(pf[(size_t)i * NPROJ]); const float f = lb + (1.f - lb) * sigmoidf_(fz); run += __logf(f); Lc[i] = run; kk[i] = 1.f - f; }
#pragma unroll
    for (int i = 0; i < 8; ++i) vp[i] = (unsigned)pv[(size_t)(2 * i) * NPROJ] | ((unsigned)pv[(size_t)(2 * i + 1) * NPROJ] << 16);
    tot[seg * 128 + d] = run;
    __syncthreads();
    const float t0 = tot[d], t1 = tot[128 + d], t2 = tot[256 + d], t3 = tot[384 + d];
    const float rem = (seg < 1 ? t1 : 0.f) + (seg < 2 ? t2 : 0.f) + (seg < 3 ? t3 : 0.f);
    unsigned kp[8];
#pragma unroll
    for (int i = 0; i < 8; ++i) { const float a0 = kk[2 * i] * __expf((run - Lc[2 * i]) + rem), a1 = kk[2 * i + 1] * __expf((run - Lc[2 * i + 1]) + rem); kp[i] = pk2(a0, a1); }
    *(LAS u32x4*)(KT + d * 72 + seg * 16) = (u32x4){kp[0], kp[1], kp[2], kp[3]}; *(LAS u32x4*)(KT + d * 72 + seg * 16 + 8) = (u32x4){kp[4], kp[5], kp[6], kp[7]};
    *(LAS u32x4*)(VT + d * 72 + seg * 16) = (u32x4){vp[0], vp[1], vp[2], vp[3]}; *(LAS u32x4*)(VT + d * 72 + seg * 16 + 8) = (u32x4){vp[4], vp[5], vp[6], vp[7]};
    if (seg == 0) dec[(size_t)item * 128 + d] = __expf(t0 + t1 + t2 + t3);
    __syncthreads();
    bf16_t* out = dS + (size_t)item * 16384;
#pragma unroll
    for (int n = 0; n < 8; ++n) { f32x4 acc = {0.f, 0.f, 0.f, 0.f};
#pragma unroll
        for (int ks = 0; ks < 2; ++ks) { const bf16x8 X = *(const LAS bf16x8*)(KT + (16 * n + r) * 72 + ks * 32 + q * 8), Y = *(const LAS bf16x8*)(VT + (16 * wid + r) * 72 + ks * 32 + q * 8); acc = mfma16(X, Y, acc); }
        u32x2 w; w.x = pk2(acc[0], acc[1]); w.y = pk2(acc[2], acc[3]); *(LAS u32x2*)(SW + r * 136 + 16 * n + 4 * q) = w; }
#pragma unroll
    for (int i = 0; i < 4; ++i) { const int id = lane + 64 * i, rw = id >> 4, c16 = id & 15; *(u32x4*)(out + (16 * wid + rw) * 128 + c16 * 8) = *(const LAS u32x4*)(SW + rw * 136 + c16 * 8); }
    __syncthreads();
}

__device__ __forceinline__ void hg_pass2(int task, bf16_t* dS, const float* dec, float* out_state) {
    const int bh = task >> 11, e = (task >> 4) & 127, d0 = (task & 15) * 8;
    float S[8];
#pragma unroll
    for (int j = 0; j < 8; ++j) S[j] = 0.f;
#pragma unroll 1
    for (int c8 = 0; c8 < 32; c8 += 8) {
        u32x4 raw[8]; f32x4 dc0[8], dc1[8];
#pragma unroll
        for (int i = 0; i < 8; ++i) { const size_t item = (size_t)bh * 32 + c8 + i; raw[i] = *(const u32x4*)(dS + (item * 128 + e) * 128 + d0);
            dc0[i] = *(const f32x4*)(dec + item * 128 + d0); dc1[i] = *(const f32x4*)(dec + item * 128 + d0 + 4); }
#pragma unroll
        for (int i = 0; i < 8; ++i) { const size_t item = (size_t)bh * 32 + c8 + i;
            u32x4 w; w.x = pk2(S[0], S[1]); w.y = pk2(S[2], S[3]); w.z = pk2(S[4], S[5]); w.w = pk2(S[6], S[7]); *(u32x4*)(dS + (item * 128 + e) * 128 + d0) = w;
            S[0] = dc0[i][0] * S[0] + __uint_as_float(raw[i].x << 16); S[1] = dc0[i][1] * S[1] + __uint_as_float(raw[i].x & 0xffff0000u);
            S[2] = dc0[i][2] * S[2] + __uint_as_float(raw[i].y << 16); S[3] = dc0[i][3] * S[3] + __uint_as_float(raw[i].y & 0xffff0000u);
            S[4] = dc1[i][0] * S[4] + __uint_as_float(raw[i].z << 16); S[5] = dc1[i][1] * S[5] + __uint_as_float(raw[i].z & 0xffff0000u);
            S[6] = dc1[i][2] * S[6] + __uint_as_float(raw[i].w << 16); S[7] = dc1[i][3] * S[7] + __uint_as_float(raw[i].w & 0xffff0000u); }
    }
#pragma unroll
    for (int j = 0; j < 8; ++j) out_state[((size_t)bh * 128 + d0 + j) * 128 + e] = S[j];
}

__device__ __forceinline__ void hg_pass3(LAS unsigned char* lds, int item, bf16_t* proj, const float* lbl, const bf16_t* SinT, const float* g_out, int ocol = C_HQ) {
    const int tid = otid(), lane = tid & 63, wid = tid >> 6, r = lane & 15, q = lane >> 4;
    const int d = tid & 127, seg = tid >> 7;
    const int c = item & 31, bh = item >> 5, h = bh & 3, b = bh >> 2;
    LAS bf16_t* QT = (LAS bf16_t*)lds;
    LAS bf16_t* QG = QT + 64 * 136;
    LAS bf16_t* KTB = QG + 64 * 136;
    LAS bf16_t* VT = KTB + 10 * 16 * 136;
    LAS bf16_t* AS = VT + 128 * 72;
    LAS float* tot = (LAS float*)(AS + 64 * 72);
    LAS float* ssq = tot + 512;
    const size_t row0 = (size_t)b * TSEQ + c * 64 + seg * 16;
    {
        const bf16_t* pq = proj + row0 * NPROJ + C_HQ + h * 128 + d;
        const bf16_t* pf = proj + row0 * NPROJ + C_HF + h * 128 + d;
        const bf16_t* pv = proj + row0 * NPROJ + C_HI + h * 128 + d;
        const float lb = lb_of(lbl, h * 128 + d);
        float Lc[16], kk[16], qq[16]; float run = 0.f; unsigned vp[8];
#pragma unroll
        for (int i = 0; i < 16; ++i) { const float fz = bf2f(pf[(size_t)i * NPROJ]); const float f = lb + (1.f - lb) * sigmoidf_(fz); run += __logf(f); Lc[i] = run; kk[i] = 1.f - f; qq[i] = bf2f(pq[(size_t)i * NPROJ]); }
#pragma unroll
        for (int i = 0; i < 8; ++i) vp[i] = (unsigned)pv[(size_t)(2 * i) * NPROJ] | ((unsigned)pv[(size_t)(2 * i + 1) * NPROJ] << 16);
        tot[seg * 128 + d] = run;
        __syncthreads();
        const float t0 = tot[d], t1 = tot[128 + d], t2 = tot[256 + d];
        const float R = (seg > 0 ? t0 : 0.f) + (seg > 1 ? t1 : 0.f) + (seg > 2 ? t2 : 0.f);
        const float eR = __expf(R);
        const int tri_d = seg * (seg + 1) / 2 + seg;
#pragma unroll
        for (int i = 0; i < 16; ++i) { const float qt = qq[i] * __expf(Lc[i]); const int t = seg * 16 + i;
            QT[t * 136 + d] = f2bf(qt); QG[t * 136 + d] = f2bf(qt * eR);
            KTB[(tri_d * 16 + i) * 136 + d] = f2bf(kk[i] * __expf(fminf(-Lc[i], 80.f))); }
        for (int ii = seg + 1; ii < 4; ++ii) { float mid = 0.f; if (seg < 1 && ii > 1) mid += t1; if (seg < 2 && ii > 2) mid += t2;
            const int tri = ii * (ii + 1) / 2 + seg;
#pragma unroll
            for (int i = 0; i < 16; ++i) KTB[(tri * 16 + i) * 136 + d] = f2bf(kk[i] * __expf((run - Lc[i]) + mid)); }
        *(LAS u32x4*)(VT + d * 72 + seg * 16) = (u32x4){vp[0], vp[1], vp[2], vp[3]}; *(LAS u32x4*)(VT + d * 72 + seg * 16 + 8) = (u32x4){vp[4], vp[5], vp[6], vp[7]};
    }
    __syncthreads();
#pragma unroll
    for (int rep = 0; rep < 2; ++rep) { const int blk = wid + rep * 8, bi = blk >> 2, bj = blk & 3; f32x4 acc = {0.f, 0.f, 0.f, 0.f};
        if (bj <= bi) { const int tri = bi * (bi + 1) / 2 + bj;
#pragma unroll
            for (int ks = 0; ks < 4; ++ks) { const bf16x8 X = *(const LAS bf16x8*)(KTB + (tri * 16 + r) * 136 + ks * 32 + q * 8), Y = *(const LAS bf16x8*)(QT + (16 * bi + r) * 136 + ks * 32 + q * 8); acc = mfma16(X, Y, acc); }
            if (bi == bj) {
#pragma unroll
                for (int jj = 0; jj < 4; ++jj) if (4 * q + jj > r) acc[jj] = 0.f; } }
        u32x2 w; w.x = pk2(acc[0], acc[1]); w.y = pk2(acc[2], acc[3]); *(LAS u32x2*)(AS + (16 * bi + r) * 72 + 16 * bj + 4 * q) = w; }
    __syncthreads();
    const int ti = wid & 3, eh = wid >> 2;
    f32x4 acc[4];
#pragma unroll
    for (int nn = 0; nn < 4; ++nn) { const int n = eh * 4 + nn; acc[nn] = (f32x4){0.f, 0.f, 0.f, 0.f};
#pragma unroll
        for (int ks = 0; ks < 2; ++ks) { const bf16x8 X = *(const LAS bf16x8*)(VT + (16 * n + r) * 72 + ks * 32 + q * 8), Y = *(const LAS bf16x8*)(AS + (16 * ti + r) * 72 + ks * 32 + q * 8); acc[nn] = mfma16(X, Y, acc[nn]); }
#pragma unroll
        for (int ks = 0; ks < 4; ++ks) { const bf16x8 X = *(const bf16x8*)(SinT + ((size_t)item * 128 + 16 * n + r) * 128 + ks * 32 + q * 8), Y = *(const LAS bf16x8*)(QG + (16 * ti + r) * 136 + ks * 32 + q * 8); acc[nn] = mfma16(X, Y, acc[nn]); } __builtin_amdgcn_sched_barrier(0); }
    float pss = 0.f;
#pragma unroll
    for (int nn = 0; nn < 4; ++nn) pss += acc[nn][0] * acc[nn][0] + acc[nn][1] * acc[nn][1] + acc[nn][2] * acc[nn][2] + acc[nn][3] * acc[nn][3];
    pss += __shfl_xor(pss, 16); pss += __shfl_xor(pss, 32);
    if (q == 0) ssq[(16 * ti + r) * 2 + eh] = pss;
    __syncthreads();
    { const int t = 16 * ti + r; const float rinv = rsqrtf((ssq[t * 2] + ssq[t * 2 + 1]) * (1.f / 128.f) + EPSF);
      bf16_t* prow = proj + ((size_t)b * TSEQ + c * 64 + t) * NPROJ;
#pragma unroll
      for (int nn = 0; nn < 4; ++nn) { const int e0 = 16 * (eh * 4 + nn) + 4 * q; const u32x2 gz = *(const u32x2*)(prow + C_HG + h * 128 + e0); const f32x4 gg = *(const f32x4*)(g_out + h * 128 + e0);
          const float v0 = acc[nn][0] * rinv * gg[0] * siluf_(__uint_as_float(gz.x << 16)), v1 = acc[nn][1] * rinv * gg[1] * siluf_(__uint_as_float(gz.x & 0xffff0000u));
          const float v2 = acc[nn][2] * rinv * gg[2] * siluf_(__uint_as_float(gz.y << 16)), v3 = acc[nn][3] * rinv * gg[3] * siluf_(__uint_as_float(gz.y & 0xffff0000u));
          u32x2 w; w.x = pk2(v0, v1); w.y = pk2(v2, v3); *(LAS u32x2*)(QT + t * 136 + e0) = w; } }
    __syncthreads();
#pragma unroll
    for (int i = 0; i < 2; ++i) { const int id = tid + 512 * i, rw = id >> 4, c16 = id & 15;
        *(u32x4*)(proj + ((size_t)b * TSEQ + c * 64 + rw) * NPROJ + ocol + h * 128 + c16 * 8) = *(const LAS u32x4*)(QT + rw * 136 + c16 * 8); }
    __syncthreads();
}

__device__ __forceinline__ void gdn_passA(LAS unsigned char* lds, int item, const bf16_t* proj, const float* ab, const float* wconv, const float* a_log, const float* dt_bias,
                                          bf16_t* uT, bf16_t* wo, bf16_t* kgT, bf16_t* qg, bf16_t* aqk, float* gcs, float* conv_out) {
    const int tid = otid(), lane = tid & 63, wid = tid >> 6, r = lane & 15, q = lane >> 4;
    const int c = item & 31, bh = item >> 5, h = bh & 3, b = bh >> 2;
    LAS bf16_t* Qb = (LAS bf16_t*)lds;
    LAS bf16_t* Kb = Qb + 64 * 136;
    LAS float* KF = (LAS float*)(Kb + 64 * 136);
    LAS float* VF = KF + 64 * 132;
    LAS float* Msm = VF + 64 * 132;
    LAS float* gl = Msm + 64 * 68;
    LAS float* be = gl + 64;
    LAS float* Gs = be + 64;
    LAS float* WC = Gs + 64;
    { const int nbw = (int)gridDim.x; const bool restage = (item < nbw) || ((((item - nbw) >> 5) & 3) != h);
      if (restage) { const int tid0 = otid(); for (int i = tid0; i < 1536; i += 512) { const int grp = i >> 9, j = (i >> 7) & 3, dd = i & 127; WC[i] = wconv[j * 1536 + grp * 512 + h * 128 + dd]; }
        __syncthreads(); } }
    {
        const int t = tid >> 3, dg = tid & 7, d0 = dg * 16;
        const int tg = c * 64 + t; const size_t row = (size_t)b * TSEQ + tg;
#pragma unroll
        for (int grp = 0; grp < 3; ++grp) { const int ch0 = grp * 512 + h * 128 + d0; float o[16];
#pragma unroll
            for (int i = 0; i < 16; ++i) o[i] = 0.f;
            u32x4 raw[4][2]; float msk[4];
#pragma unroll
            for (int j = 0; j < 4; ++j) { const bool ok = (tg - 3 + j >= 0); msk[j] = ok ? 1.f : 0.f; const bf16_t* pr = proj + (ok ? row - 3 + j : row) * NPROJ + C_GQKV + ch0;
                raw[j][0] = *(const u32x4*)pr; raw[j][1] = *(const u32x4*)(pr + 8); }
#pragma unroll
            for (int j = 0; j < 4; ++j) { const u32x4 u0 = raw[j][0], u1 = raw[j][1];
                    const unsigned uu[8] = {u0.x, u0.y, u0.z, u0.w, u1.x, u1.y, u1.z, u1.w};
#pragma unroll
                    for (int i = 0; i < 8; ++i) { const f32x2 wv = *(const LAS f32x2*)(WC + (grp * 4 + j) * 128 + d0 + 2 * i) * msk[j]; const float lo = __uint_as_float(uu[i] << 16), hi = __uint_as_float(uu[i] & 0xffff0000u);
                        o[2 * i] += wv[0] * lo; o[2 * i + 1] += wv[1] * hi; }
                    asm volatile("" : "+v"(o[0]), "+v"(o[1]), "+v"(o[14]), "+v"(o[15]) :: "memory"); }
            asm volatile("" ::: "memory");
            if (c == 31 && t >= 61) {
                const bf16_t* pr = proj + row * NPROJ + C_GQKV + ch0; const u32x4 u0 = *(const u32x4*)pr, u1 = *(const u32x4*)(pr + 8); const unsigned uu[8] = {u0.x, u0.y, u0.z, u0.w, u1.x, u1.y, u1.z, u1.w};
#pragma unroll
                for (int i = 0; i < 8; ++i) { conv_out[((size_t)b * 3 + (t - 61)) * 1536 + ch0 + 2 * i] = __uint_as_float(uu[i] << 16); conv_out[((size_t)b * 3 + (t - 61)) * 1536 + ch0 + 2 * i + 1] = __uint_as_float(uu[i] & 0xffff0000u); } }
#pragma unroll
            for (int i = 0; i < 16; ++i) o[i] = siluf_(o[i]);
            if (grp < 2) {
                float sq = 0.f;
#pragma unroll
                for (int i = 0; i < 16; ++i) sq += o[i] * o[i];
                sq += __shfl_xor(sq, 1); sq += __shfl_xor(sq, 2); sq += __shfl_xor(sq, 4);
                const float rn = rsqrtf(sq + EPSF) * (grp == 0 ? 0.08838834764831845f : 1.0f);
                unsigned pp[8];
#pragma unroll
                for (int i = 0; i < 16; ++i) o[i] *= rn;
#pragma unroll
                for (int i = 0; i < 8; ++i) pp[i] = pk2(o[2 * i], o[2 * i + 1]);
                LAS bf16_t* dstb = (grp == 0 ? Qb : Kb) + t * 136 + d0;
                *(LAS u32x4*)dstb = (u32x4){pp[0], pp[1], pp[2], pp[3]}; *(LAS u32x4*)(dstb + 8) = (u32x4){pp[4], pp[5], pp[6], pp[7]};
                if (grp == 1) {
#pragma unroll
                    for (int i = 0; i < 4; ++i) *(LAS f32x4*)(KF + t * 132 + d0 + 4 * i) = (f32x4){o[4 * i], o[4 * i + 1], o[4 * i + 2], o[4 * i + 3]}; }
            } else {
#pragma unroll
                for (int i = 0; i < 4; ++i) *(LAS f32x4*)(VF + t * 132 + d0 + 4 * i) = (f32x4){o[4 * i], o[4 * i + 1], o[4 * i + 2], o[4 * i + 3]}; }
            asm volatile("" ::: "memory"); }
        if (dg == 0) { KA ap2 = kargs(); const float* ab2 = (const float*)(ap2->ws + WS_AB); const float ar = ab2[row * 8 + h], br = ab2[row * 8 + 4 + h]; be[t] = sigmoidf_(br); gl[t] = -__expf(ap2->in[12][h]) * softplusf_(ar + ap2->in[13][h]); }
    }
    __syncthreads();
    { float g = gl[lane];
#pragma unroll
        for (int o = 1; o < 64; o <<= 1) { const float v = __shfl_up(g, o); if (lane >= o) g += v; }
        Gs[lane] = g; }
    {
        const int ti = wid >> 1; const int t = 16 * ti + r; const float Gt = Gs[t], bet = be[t];
#pragma unroll
        for (int sx = 0; sx < 2; ++sx) { const int sj = (wid & 1) * 2 + sx; f32x4 aK = {0.f, 0.f, 0.f, 0.f}, aQ = {0.f, 0.f, 0.f, 0.f};
            if (sj <= ti) {
#pragma unroll
                for (int ks = 0; ks < 4; ++ks) { const bf16x8 X = *(const LAS bf16x8*)(Kb + (16 * sj + r) * 136 + ks * 32 + q * 8);
                    const bf16x8 Y1 = *(const LAS bf16x8*)(Kb + (16 * ti + r) * 136 + ks * 32 + q * 8), Y2 = *(const LAS bf16x8*)(Qb + (16 * ti + r) * 136 + ks * 32 + q * 8);
                    aK = mfma16(X, Y1, aK); aQ = mfma16(X, Y2, aQ); } }
            f32x4 mv, av;
#pragma unroll
            for (int jj = 0; jj < 4; ++jj) { const int s = 16 * sj + 4 * q + jj; const float dcy = (s <= t) ? __expf(Gt - Gs[s]) : 0.f; mv[jj] = (s < t) ? bet * dcy * aK[jj] : 0.f; av[jj] = dcy * aQ[jj]; }
            *(LAS f32x4*)(Msm + t * 68 + 16 * sj + 4 * q) = mv;
            u32x2 w; w.x = pk2(av[0], av[1]); w.y = pk2(av[2], av[3]); *(u32x2*)(aqk + (size_t)item * 4096 + t * 64 + 16 * sj + 4 * q) = w; }
    }
    __syncthreads();
    const float GC = Gs[63];
    if (tid < 256) {
        const int col = tid; float X[64];
        const LAS float* rsrc = (col < 128) ? VF + col : KF + (col - 128);
#pragma unroll
        for (int blk = 0; blk < 4; ++blk) { float a[16];
#pragma unroll
            for (int rr = 0; rr < 16; ++rr) { const int t = 16 * blk + rr; a[rr] = rsrc[t * 132] * be[t] * (col < 128 ? 1.f : __expf(Gs[t])); }
#pragma unroll
            for (int s4 = 0; s4 < 16 * blk; s4 += 4) {
#pragma unroll
                for (int rr = 0; rr < 16; ++rr) { const f32x4 m = *(const LAS f32x4*)(Msm + (16 * blk + rr) * 68 + s4);
                    a[rr] -= m[0] * X[s4]; a[rr] -= m[1] * X[s4 + 1]; a[rr] -= m[2] * X[s4 + 2]; a[rr] -= m[3] * X[s4 + 3]; }
                asm volatile("" ::: "memory"); }
#pragma unroll
            for (int rr = 0; rr < 16; ++rr) { const int t = 16 * blk + rr; float av = a[rr];
#pragma unroll
                for (int s4 = 16 * blk; s4 < t; s4 += 4) { const f32x4 m = *(const LAS f32x4*)(Msm + t * 68 + s4);
#pragma unroll
                    for (int jj = 0; jj < 4; ++jj) if (s4 + jj < t) av -= m[jj] * X[s4 + jj]; }
                asm volatile("" : "+v"(av) :: "memory"); X[t] = av; } }
        if (col < 128) { bf16_t* dst = uT + (size_t)item * 8192 + col * 64;
#pragma unroll
            for (int i = 0; i < 8; ++i) { u32x4 w; w.x = pk2(X[8 * i], X[8 * i + 1]); w.y = pk2(X[8 * i + 2], X[8 * i + 3]); w.z = pk2(X[8 * i + 4], X[8 * i + 5]); w.w = pk2(X[8 * i + 6], X[8 * i + 7]); *(u32x4*)(dst + 8 * i) = w; } }
        else { bf16_t* dst = wo + (size_t)item * 8192 + (col - 128);
#pragma unroll
            for (int t = 0; t < 64; ++t) dst[t * 128] = f2bf(X[t]); }
    } else {
        const int tt = tid - 256;
#pragma unroll
        for (int i = 0; i < 4; ++i) { const int ch = tt + i * 256, t = ch >> 4, d8 = (ch & 15) * 8; const u32x4 raw = *(const LAS u32x4*)(Qb + t * 136 + d8); const float eg = __expf(Gs[t]);
            u32x4 w; w.x = pk2(__uint_as_float(raw.x << 16) * eg, __uint_as_float(raw.x & 0xffff0000u) * eg); w.y = pk2(__uint_as_float(raw.y << 16) * eg, __uint_as_float(raw.y & 0xffff0000u) * eg);
            w.z = pk2(__uint_as_float(raw.z << 16) * eg, __uint_as_float(raw.z & 0xffff0000u) * eg); w.w = pk2(__uint_as_float(raw.w << 16) * eg, __uint_as_float(raw.w & 0xffff0000u) * eg);
            *(u32x4*)(qg + (size_t)item * 8192 + t * 128 + d8) = w; }
        { const int d = tt & 127, hf = tt >> 7; bf16_t* dst = kgT + (size_t)item * 8192 + d * 64 + hf * 32;
#pragma unroll
          for (int i = 0; i < 4; ++i) { float v[8];
#pragma unroll
              for (int j = 0; j < 8; ++j) { const int t = hf * 32 + i * 8 + j; v[j] = KF[t * 132 + d] * __expf(GC - Gs[t]); }
              u32x4 w; w.x = pk2(v[0], v[1]); w.y = pk2(v[2], v[3]); w.z = pk2(v[4], v[5]); w.w = pk2(v[6], v[7]); *(u32x4*)(dst + i * 8) = w; } }
        if (tt == 0) gcs[item] = __expf(GC);
    }
    __syncthreads();
}

__device__ __forceinline__ void gdn_passB(LAS unsigned char* lds, int bh, bf16_t* uT, bf16_t* wo, bf16_t* kgT, const float* gcs, float* out_state) {
    const int tid = otid(), lane = tid & 63, wid = tid >> 6, r = lane & 15, q = lane >> 4;
    const int e0 = 16 * wid;
    constexpr int BUF = 64 * 136 + 128 * 72;
    LAS bf16_t* L0 = (LAS bf16_t*)lds;
    LAS bf16_t* SW = L0 + 2 * BUF + wid * (16 * 136 + 16 * 72);
    LAS bf16_t* VW = SW + 16 * 136;
    u32x4 pw[2][2], pk[2][2]; u32x2 pu[2][4];
    const int rw0 = tid >> 4, cw = (tid & 15) * 8;
    const int rk0 = tid >> 3, ck = (tid & 7) * 8;
#define GB_LOAD(S_, item_) do { const size_t it_ = (size_t)(item_); \
        pw[S_][0] = *(const u32x4*)(wo + it_ * 8192 + rw0 * 128 + cw); pw[S_][1] = *(const u32x4*)(wo + it_ * 8192 + (rw0 + 32) * 128 + cw); \
        pk[S_][0] = *(const u32x4*)(kgT + it_ * 8192 + rk0 * 64 + ck); pk[S_][1] = *(const u32x4*)(kgT + it_ * 8192 + (rk0 + 64) * 64 + ck); \
        _Pragma("unroll") for (int ti_ = 0; ti_ < 4; ++ti_) pu[S_][ti_] = *(const u32x2*)(uT + it_ * 8192 + (e0 + r) * 64 + 16 * ti_ + 4 * q); } while (0)
#define GB_STORE(S_, buf_) do { LAS bf16_t* W_ = L0 + (buf_) * BUF; LAS bf16_t* K_ = W_ + 64 * 136; \
        *(LAS u32x4*)(W_ + rw0 * 136 + cw) = pw[S_][0]; *(LAS u32x4*)(W_ + (rw0 + 32) * 136 + cw) = pw[S_][1]; \
        *(LAS u32x4*)(K_ + rk0 * 72 + ck) = pk[S_][0]; *(LAS u32x4*)(K_ + (rk0 + 64) * 72 + ck) = pk[S_][1]; } while (0)
    const float gcl = (lane < 32) ? gcs[bh * 32 + lane] : 0.f;
    u32x2 ucur[4], unext[4];
    GB_LOAD(0, bh * 32);
    GB_LOAD(1, bh * 32 + 1);
    GB_STORE(0, 0);
#pragma unroll
    for (int ti = 0; ti < 4; ++ti) ucur[ti] = pu[0][ti];
    GB_LOAD(0, bh * 32 + 2);
    f32x4 Sacc[8];
#pragma unroll
    for (int i = 0; i < 8; ++i) Sacc[i] = (f32x4){0.f, 0.f, 0.f, 0.f};
    asm volatile("s_waitcnt lgkmcnt(0)" ::: "memory"); __builtin_amdgcn_s_barrier(); asm volatile("" ::: "memory");
#define GB_STEP(c_, S1_) do { const int c = (c_); const size_t item = (size_t)bh * 32 + c; \
        const LAS bf16_t* W = L0 + (c & 1) * BUF; const LAS bf16_t* KGT = W + 64 * 136; \
        if (c < 31) { GB_STORE(S1_, (c + 1) & 1); _Pragma("unroll") for (int ti = 0; ti < 4; ++ti) unext[ti] = pu[S1_][ti]; if (c < 29) GB_LOAD(S1_, item + 3); } \
        const float gc = __shfl(gcl, c); \
        bf16x8 Sf[4]; \
        _Pragma("unroll") for (int ks = 0; ks < 4; ++ks) Sf[ks] = pkfrag(Sacc[2 * ks], Sacc[2 * ks + 1]); \
        { _Pragma("unroll") for (int ks = 0; ks < 4; ++ks) { const u32x4 raw = *(const u32x4*)&Sf[ks]; *(LAS u32x2*)(SW + r * 136 + 32 * ks + 4 * q) = (u32x2){raw.x, raw.y}; *(LAS u32x2*)(SW + r * 136 + 32 * ks + 16 + 4 * q) = (u32x2){raw.z, raw.w}; } \
          bf16_t* dst = (wid < 4 ? wo + item * 8192 + e0 * 128 : kgT + item * 8192 + (e0 - 64) * 128); \
          _Pragma("unroll") for (int i = 0; i < 4; ++i) { const int id = lane + 64 * i, rw = id >> 4, c16 = id & 15; *(u32x4*)(dst + rw * 128 + c16 * 8) = *(const LAS u32x4*)(SW + rw * 136 + c16 * 8); } } \
        f32x4 P[4]; \
        _Pragma("unroll") for (int ti = 0; ti < 4; ++ti) P[ti] = (f32x4){0.f, 0.f, 0.f, 0.f}; \
        _Pragma("unroll") for (int ks = 0; ks < 4; ++ks) \
            _Pragma("unroll") for (int ti = 0; ti < 4; ++ti) { const LAS bf16_t* pwp = W + (16 * ti + r) * 136 + 32 * ks + 4 * q; P[ti] = mfma16(ld2x4(pwp, pwp + 16), Sf[ks], P[ti]); } \
        f32x4 vn[4]; \
        _Pragma("unroll") for (int ti = 0; ti < 4; ++ti) { const u32x2 uu = ucur[ti]; \
            vn[ti][0] = __uint_as_float(uu.x << 16) - P[ti][0]; vn[ti][1] = __uint_as_float(uu.x & 0xffff0000u) - P[ti][1]; \
            vn[ti][2] = __uint_as_float(uu.y << 16) - P[ti][2]; vn[ti][3] = __uint_as_float(uu.y & 0xffff0000u) - P[ti][3]; \
            u32x2 w; w.x = pk2(vn[ti][0], vn[ti][1]); w.y = pk2(vn[ti][2], vn[ti][3]); *(LAS u32x2*)(VW + r * 72 + 16 * ti + 4 * q) = w; } \
        { bf16_t* dstv = uT + item * 8192 + e0 * 64; \
          _Pragma("unroll") for (int i = 0; i < 2; ++i) { const int id = lane + 64 * i, rw = id >> 3, c8 = id & 7; *(u32x4*)(dstv + rw * 64 + c8 * 8) = *(const LAS u32x4*)(VW + rw * 72 + c8 * 8); } } \
        bf16x8 Vf[2]; \
        Vf[0] = pkfrag(vn[0], vn[1]); Vf[1] = pkfrag(vn[2], vn[3]); \
        _Pragma("unroll") for (int dt = 0; dt < 8; ++dt) Sacc[dt] = Sacc[dt] * gc; \
        _Pragma("unroll") for (int k2 = 0; k2 < 2; ++k2) \
            _Pragma("unroll") for (int dt = 0; dt < 8; ++dt) { const LAS bf16_t* pp = KGT + (16 * dt + r) * 72 + 32 * k2 + 4 * q; Sacc[dt] = mfma16(ld2x4(pp, pp + 16), Vf[k2], Sacc[dt]); } \
        _Pragma("unroll") for (int ti = 0; ti < 4; ++ti) ucur[ti] = unext[ti]; \
        asm volatile("s_waitcnt lgkmcnt(0)" ::: "memory"); __builtin_amdgcn_s_barrier(); asm volatile("" ::: "memory"); } while (0)
#pragma unroll 1
    for (int c2 = 0; c2 < 32; c2 += 2) { GB_STEP(c2, 1); GB_STEP(c2 + 1, 0); }
#undef GB_STEP
#undef GB_LOAD
#undef GB_STORE
#pragma unroll
    for (int dt = 0; dt < 8; ++dt)
#pragma unroll
        for (int jj = 0; jj < 4; ++jj) out_state[((size_t)bh * 128 + 16 * dt + 4 * q + jj) * 128 + e0 + r] = Sacc[dt][jj];
    __syncthreads();
}
__device__ __forceinline__ void gdn_passC(LAS unsigned char* lds, int item, bf16_t* proj, const bf16_t* vnT, const bf16_t* st_lo, const bf16_t* st_hi, const bf16_t* qg, const bf16_t* aqk, const float* g_out, int ocol = C_GQKV) {
    const int tid = otid(), lane = tid & 63, wid = tid >> 6, r = lane & 15, q = lane >> 4;
    const int c = item & 31, bh = item >> 5, h = bh & 3, b = bh >> 2;
    LAS float* ssq = (LAS float*)lds;
    LAS bf16_t* OT = (LAS bf16_t*)(lds + 1024);
    const int ti = wid & 3, eh = wid >> 2;
    const bf16_t* ST = (eh == 0 ? st_lo : st_hi) + (size_t)item * 8192;
    bf16x8 Yq[4], Ya[2];
#pragma unroll
    for (int ks = 0; ks < 4; ++ks) Yq[ks] = *(const bf16x8*)(qg + (size_t)item * 8192 + (16 * ti + r) * 128 + ks * 32 + q * 8);
#pragma unroll
    for (int ks = 0; ks < 2; ++ks) Ya[ks] = *(const bf16x8*)(aqk + (size_t)item * 4096 + (16 * ti + r) * 64 + ks * 32 + q * 8);
    f32x4 acc[4];
#pragma unroll
    for (int nn = 0; nn < 4; ++nn) { const int n = eh * 4 + nn; acc[nn] = (f32x4){0.f, 0.f, 0.f, 0.f};
#pragma unroll
        for (int ks = 0; ks < 4; ++ks) { const bf16x8 X = *(const bf16x8*)(ST + (16 * nn + r) * 128 + ks * 32 + q * 8); acc[nn] = mfma16(X, Yq[ks], acc[nn]); }
#pragma unroll
        for (int ks = 0; ks < 2; ++ks) { const bf16x8 X = *(const bf16x8*)(vnT + (size_t)item * 8192 + (16 * n + r) * 64 + ks * 32 + q * 8); acc[nn] = mfma16(X, Ya[ks], acc[nn]); } }
    float pss = 0.f;
#pragma unroll
    for (int nn = 0; nn < 4; ++nn) pss += acc[nn][0] * acc[nn][0] + acc[nn][1] * acc[nn][1] + acc[nn][2] * acc[nn][2] + acc[nn][3] * acc[nn][3];
    pss += __shfl_xor(pss, 16); pss += __shfl_xor(pss, 32);
    if (q == 0) ssq[(16 * ti + r) * 2 + eh] = pss;
    __syncthreads();
    { const int t = 16 * ti + r; const float rinv = rsqrtf((ssq[t * 2] + ssq[t * 2 + 1]) * (1.f / 128.f) + EPSF);
      bf16_t* prow = proj + ((size_t)b * TSEQ + c * 64 + t) * NPROJ;
#pragma unroll
      for (int nn = 0; nn < 4; ++nn) { const int e0 = 16 * (eh * 4 + nn) + 4 * q; const u32x2 gz = *(const u32x2*)(prow + C_GZ + h * 128 + e0); const f32x4 gg = *(const f32x4*)(g_out + e0);
          const float v0 = acc[nn][0] * rinv * gg[0] * siluf_(__uint_as_float(gz.x << 16)), v1 = acc[nn][1] * rinv * gg[1] * siluf_(__uint_as_float(gz.x & 0xffff0000u));
          const float v2 = acc[nn][2] * rinv * gg[2] * siluf_(__uint_as_float(gz.y << 16)), v3 = acc[nn][3] * rinv * gg[3] * siluf_(__uint_as_float(gz.y & 0xffff0000u));
          u32x2 w; w.x = pk2(v0, v1); w.y = pk2(v2, v3); *(LAS u32x2*)(OT + t * 136 + e0) = w; } }
    __syncthreads();
#pragma unroll
    for (int i = 0; i < 2; ++i) { const int id = tid + 512 * i, rw = id >> 4, c16 = id & 15;
        *(u32x4*)(proj + ((size_t)b * TSEQ + c * 64 + rw) * NPROJ + ocol + h * 128 + c16 * 8) = *(const LAS u32x4*)(OT + rw * 136 + c16 * 8); }
    __syncthreads();
}

__device__ __forceinline__ void hg_sample(LAS unsigned char* lds, int it, bf16_t* proj, const float* lbl, const float* st_in, float* st_out, const float* g_out, bf16_t* oproj) {
    const int tid = otid(), lane = tid & 63, wid = tid >> 6, sub = tid >> 8, hf = (tid >> 7) & 1, e = tid & 127;
    const int bh = it * 2 + sub, b = bh >> 2, h = bh & 3;
    LAS float* qs = (LAS float*)lds; LAS float* fs = qs + 1024; LAS float* ks = fs + 1024; LAS float* red = ks + 1024; LAS float* po = red + 64;
    float v[4], gt[4];
    { const float lb = lb_of(lbl, h * 128 + e);
#pragma unroll
      for (int t = 0; t < 4; ++t) { const bf16_t* pr = proj + ((size_t)MP + b * 4 + t) * NPROJ + h * 128 + e; const float f = lb + (1.f - lb) * sigmoidf_(bf2f(pr[C_HF]));
          if (hf == 0) { qs[(sub * 4 + t) * 128 + e] = bf2f(pr[C_HQ]); fs[(sub * 4 + t) * 128 + e] = f; ks[(sub * 4 + t) * 128 + e] = 1.f - f; }
          v[t] = bf2f(pr[C_HI]); gt[t] = bf2f(pr[C_HG]); } }
    __syncthreads();
    float S[64]; const float* sp = st_in + (size_t)bh * 16384 + (size_t)hf * 8192 + e;
#pragma unroll
    for (int d8 = 0; d8 < 64; d8 += 8) {
#pragma unroll
        for (int j = 0; j < 8; ++j) S[d8 + j] = __builtin_nontemporal_load(sp + j * 128);
        sp += 1024; asm volatile("" ::: "memory"); }
    float ot[4];
#pragma unroll
    for (int t = 0; t < 4; ++t) { float o = 0.f; asm volatile("" ::: "memory"); const LAS float* fq = fs + (sub * 4 + t) * 128 + hf * 64; const LAS float* kq = ks + (sub * 4 + t) * 128 + hf * 64; const LAS float* qq = qs + (sub * 4 + t) * 128 + hf * 64;
#pragma unroll
        for (int d4 = 0; d4 < 64; d4 += 4) { const f32x4 f4 = *(const LAS f32x4*)(fq + d4), k4 = *(const LAS f32x4*)(kq + d4), q4 = *(const LAS f32x4*)(qq + d4);
#pragma unroll
            for (int j = 0; j < 4; ++j) { S[d4 + j] = f4[j] * S[d4 + j] + k4[j] * v[t]; o += q4[j] * S[d4 + j]; }
            asm volatile("" : "+v"(S[d4]), "+v"(S[d4 + 1]), "+v"(S[d4 + 2]), "+v"(S[d4 + 3]), "+v"(o) :: "memory"); }
        ot[t] = o; }
    float* op = st_out + (size_t)bh * 16384 + (size_t)hf * 8192 + e;
#pragma unroll
    for (int d8 = 0; d8 < 64; d8 += 8) {
#pragma unroll
        for (int j = 0; j < 8; ++j) __builtin_nontemporal_store(S[d8 + j], op + j * 128);
        op += 1024; asm volatile("" ::: "memory"); }
#pragma unroll
    for (int t = 0; t < 4; ++t) po[((sub * 2 + hf) * 4 + t) * 128 + e] = ot[t];
    __syncthreads();
#pragma unroll
    for (int t = 0; t < 4; ++t) { ot[t] = po[((sub * 2) * 4 + t) * 128 + e] + po[((sub * 2 + 1) * 4 + t) * 128 + e]; const float p = wave_sum(ot[t] * ot[t]); if (lane == 0 && hf == 0) red[(sub * 4 + t) * 4 + (wid & 1)] = p; }
    __syncthreads();
    if (hf == 0) { const float gg = g_out[h * 128 + e];
#pragma unroll
        for (int t = 0; t < 4; ++t) { const float tot = red[(sub * 4 + t) * 4] + red[(sub * 4 + t) * 4 + 1]; const float rinv = rsqrtf(tot * (1.f / 128.f) + EPSF);
            oproj[((size_t)MP + b * 4 + t) * NPROJ + C_HQ + h * 128 + e] = f2bf(ot[t] * rinv * gg * siluf_(gt[t])); } }
    __syncthreads();
}
__device__ __forceinline__ void gdn_sample(LAS unsigned char* lds, int it, bf16_t* proj, const float* ab, const float* wconv, const float* a_log, const float* dt_bias, const float* cv_in, float* cv_out,
                                           const float* st_in, float* st_out, const float* g_out, bf16_t* oproj) {
    const int tid = otid(), lane = tid & 63, wid = tid >> 6, sub = tid >> 8, hf = (tid >> 7) & 1, e = tid & 127;
    const int bh = it * 2 + sub, b = bh >> 2, h = bh & 3;
    LAS float* qs = (LAS float*)lds; LAS float* ks = qs + 1024; LAS float* red = ks + 1024; LAS float* po = red + 64;
    float x[3][4];
#pragma unroll
    for (int grp = 0; grp < 3; ++grp) { const int ch = grp * 512 + h * 128 + e; float u[7], w[4];
#pragma unroll
        for (int j = 0; j < 3; ++j) u[j] = cv_in[((size_t)b * 3 + j) * 1536 + ch];
#pragma unroll
        for (int t = 0; t < 4; ++t) u[3 + t] = bf2f(proj[((size_t)MP + b * 4 + t) * NPROJ + C_GQKV + ch]);
#pragma unroll
        for (int j = 0; j < 4; ++j) w[j] = wconv[j * 1536 + ch];
#pragma unroll
        for (int t = 0; t < 4; ++t) x[grp][t] = siluf_(w[0] * u[t] + w[1] * u[t + 1] + w[2] * u[t + 2] + w[3] * u[t + 3]);
        if (hf == 0) {
#pragma unroll
            for (int j = 0; j < 3; ++j) cv_out[((size_t)b * 3 + j) * 1536 + ch] = u[4 + j]; } }
#pragma unroll
    for (int t = 0; t < 4; ++t) { const float pq = wave_sum(x[0][t] * x[0][t]), pk = wave_sum(x[1][t] * x[1][t]);
        if (lane == 0 && hf == 0) { red[(sub * 8 + t) * 4 + (wid & 1)] = pq; red[(sub * 8 + 4 + t) * 4 + (wid & 1)] = pk; } }
    __syncthreads();
    float beta[4], av[4], zt[4];
#pragma unroll
    for (int t = 0; t < 4; ++t) { const float sq = red[(sub * 8 + t) * 4] + red[(sub * 8 + t) * 4 + 1], sk = red[(sub * 8 + 4 + t) * 4] + red[(sub * 8 + 4 + t) * 4 + 1];
        if (hf == 0) { qs[(sub * 4 + t) * 128 + e] = x[0][t] * rsqrtf(sq + EPSF) * 0.08838834764831845f; ks[(sub * 4 + t) * 128 + e] = x[1][t] * rsqrtf(sk + EPSF); }
        const size_t row = (size_t)MP + b * 4 + t; beta[t] = sigmoidf_(ab[row * 8 + 4 + h]); av[t] = __expf(-__expf(a_log[h]) * softplusf_(ab[row * 8 + h] + dt_bias[h]));
        zt[t] = bf2f(proj[row * NPROJ + C_GZ + h * 128 + e]); }
    __syncthreads();
    float S[64]; const float* sp = st_in + (size_t)bh * 16384 + (size_t)hf * 8192 + e;
#pragma unroll
    for (int d8 = 0; d8 < 64; d8 += 8) {
#pragma unroll
        for (int j = 0; j < 8; ++j) S[d8 + j] = __builtin_nontemporal_load(sp + j * 128);
        sp += 1024; asm volatile("" ::: "memory"); }
    float ot[4];
#pragma unroll
    for (int t = 0; t < 4; ++t) { const LAS float* kq = ks + (sub * 4 + t) * 128 + hf * 64; const LAS float* qq = qs + (sub * 4 + t) * 128 + hf * 64; float kS = 0.f;
#pragma unroll
        for (int d4 = 0; d4 < 64; d4 += 4) { const f32x4 k4 = *(const LAS f32x4*)(kq + d4);
#pragma unroll
            for (int j = 0; j < 4; ++j) kS += k4[j] * S[d4 + j];
            asm volatile("" : "+v"(kS) :: "memory"); }
        po[((sub * 2 + hf) * 4 + t) * 128 + e] = kS;
        __syncthreads();
        kS = po[((sub * 2) * 4 + t) * 128 + e] + po[((sub * 2 + 1) * 4 + t) * 128 + e];
        const float a = av[t], vn = beta[t] * (x[2][t] - a * kS); float o = 0.f;
#pragma unroll
        for (int d4 = 0; d4 < 64; d4 += 4) { const f32x4 k4 = *(const LAS f32x4*)(kq + d4), q4 = *(const LAS f32x4*)(qq + d4);
#pragma unroll
            for (int j = 0; j < 4; ++j) { S[d4 + j] = a * S[d4 + j] + k4[j] * vn; o += q4[j] * S[d4 + j]; }
            asm volatile("" : "+v"(S[d4]), "+v"(S[d4 + 1]), "+v"(S[d4 + 2]), "+v"(S[d4 + 3]), "+v"(o) :: "memory"); }
        ot[t] = o; }
    float* op = st_out + (size_t)bh * 16384 + (size_t)hf * 8192 + e;
#pragma unroll
    for (int d8 = 0; d8 < 64; d8 += 8) {
#pragma unroll
        for (int j = 0; j < 8; ++j) __builtin_nontemporal_store(S[d8 + j], op + j * 128);
        op += 1024; asm volatile("" ::: "memory"); }
    __syncthreads();
#pragma unroll
    for (int t = 0; t < 4; ++t) po[((sub * 2 + hf) * 4 + t) * 128 + e] = ot[t];
    __syncthreads();
#pragma unroll
    for (int t = 0; t < 4; ++t) { ot[t] = po[((sub * 2) * 4 + t) * 128 + e] + po[((sub * 2 + 1) * 4 + t) * 128 + e]; const float p = wave_sum(ot[t] * ot[t]); if (lane == 0 && hf == 0) red[(sub * 8 + t) * 4 + (wid & 1)] = p; }
    __syncthreads();
    if (hf == 0) { const float gg = g_out[e];
#pragma unroll
        for (int t = 0; t < 4; ++t) { const float tot = red[(sub * 8 + t) * 4] + red[(sub * 8 + t) * 4 + 1]; const float rinv = rsqrtf(tot * (1.f / 128.f) + EPSF);
            oproj[((size_t)MP + b * 4 + t) * NPROJ + C_GQKV + h * 128 + e] = f2bf(ot[t] * rinv * gg * siluf_(zt[t])); } }
    __syncthreads();
}

template <bool SAMPLE>
__device__ __forceinline__ void attn_item(LAS unsigned char* lds, int idx, bf16_t* proj, const bf16_t* mk, const bf16_t* mv, const float* ck, const float* cv) {
    const int tid = otid(), lane = tid & 63, wid = tid >> 6, r = lane & 15, q = lane >> 4;
    LAS bf16_t* Ks = (LAS bf16_t*)lds;
    LAS bf16_t* VT = Ks + 256 * 136;
    int b, h, qc = 0;
    if (SAMPLE) { b = idx >> 2; h = idx & 3; } else { b = idx >> 6; h = (idx >> 4) & 3; qc = idx & 15; }
#pragma unroll
    for (int i = 0; i < 8; ++i) { const int ch = tid + i * 512, key = ch >> 4, dg = ch & 15; u32x4 kv, vv;
        if (SAMPLE) { const float* pk_ = ck + (((size_t)b * 256 + key) * 4 + h) * 128 + dg * 8; const float* pv_ = cv + (((size_t)b * 256 + key) * 4 + h) * 128 + dg * 8;
            const f32x4 k0 = __builtin_nontemporal_load((const f32x4*)pk_), k1 = __builtin_nontemporal_load((const f32x4*)(pk_ + 4)), v0 = __builtin_nontemporal_load((const f32x4*)pv_), v1 = __builtin_nontemporal_load((const f32x4*)(pv_ + 4));
            kv.x = pk2(k0[0], k0[1]); kv.y = pk2(k0[2], k0[3]); kv.z = pk2(k1[0], k1[1]); kv.w = pk2(k1[2], k1[3]);
            vv.x = pk2(v0[0], v0[1]); vv.y = pk2(v0[2], v0[3]); vv.z = pk2(v1[0], v1[1]); vv.w = pk2(v1[2], v1[3]); }
        else { kv = *(const u32x4*)(mk + ((size_t)b * 256 + key) * 512 + h * 128 + dg * 8); vv = *(const u32x4*)(mv + ((size_t)b * 256 + key) * 512 + h * 128 + dg * 8); }
        *(LAS u32x4*)(Ks + key * 136 + dg * 8) = kv;
        LAS bf16_t* vt = VT + (dg * 8) * 264 + key;
        vt[0] = (bf16_t)(vv.x & 0xffff); vt[264] = (bf16_t)(vv.x >> 16); vt[2 * 264] = (bf16_t)(vv.y & 0xffff); vt[3 * 264] = (bf16_t)(vv.y >> 16);
        vt[4 * 264] = (bf16_t)(vv.z & 0xffff); vt[5 * 264] = (bf16_t)(vv.z >> 16); vt[6 * 264] = (bf16_t)(vv.w & 0xffff); vt[7 * 264] = (bf16_t)(vv.w >> 16); }
    __syncthreads();
    if (!SAMPLE || wid == 0) {
        LAS bf16_t* Ksl = Ks; LAS bf16_t* VTl = VT;
        const size_t row0 = SAMPLE ? ((size_t)MP + b * 4) : ((size_t)b * TSEQ + qc * 128 + wid * 16);
        const int tq = SAMPLE ? (r & 3) : r;
        bf16_t* qrow = proj + (row0 + tq) * NPROJ + C_MQ + h * 128;
        bf16x8 Yq[4];
#pragma unroll
        for (int ks = 0; ks < 4; ++ks) Yq[ks] = *(const bf16x8*)(qrow + ks * 32 + q * 8);
        f32x4 sacc[16];
#pragma unroll
        for (int kt = 0; kt < 16; ++kt) { sacc[kt] = (f32x4){0.f, 0.f, 0.f, 0.f};
#pragma unroll
            for (int ks = 0; ks < 4; ++ks) { const bf16x8 X = *(const LAS bf16x8*)(Ksl + (16 * kt + r) * 136 + ks * 32 + q * 8); sacc[kt] = mfma16(X, Yq[ks], sacc[kt]); } __builtin_amdgcn_sched_barrier(0); }
        float m = -1e30f;
#pragma unroll
        for (int kt = 0; kt < 16; ++kt) m = fmaxf(m, fmaxf(fmaxf(sacc[kt][0], sacc[kt][1]), fmaxf(sacc[kt][2], sacc[kt][3])));
        m = fmaxf(m, __shfl_xor(m, 16)); m = fmaxf(m, __shfl_xor(m, 32));
        float sum = 0.f;
#pragma unroll
        for (int kt = 0; kt < 16; ++kt)
#pragma unroll
            for (int jj = 0; jj < 4; ++jj) { const float p = __expf((sacc[kt][jj] - m) * 0.08838834764831845f); sacc[kt][jj] = p; sum += p; }
        sum += __shfl_xor(sum, 16); sum += __shfl_xor(sum, 32);
        f32x4 oacc[8];
#pragma unroll
        for (int et = 0; et < 8; ++et) oacc[et] = (f32x4){0.f, 0.f, 0.f, 0.f};
#pragma unroll
        for (int k8 = 0; k8 < 8; ++k8) { const bf16x8 Pf = pkfrag(sacc[2 * k8], sacc[2 * k8 + 1]);
#pragma unroll
            for (int et = 0; et < 8; ++et) { const LAS bf16_t* pp = VTl + (16 * et + r) * 264 + 32 * k8 + 4 * q; oacc[et] = mfma16(ld2x4(pp, pp + 16), Pf, oacc[et]); } __builtin_amdgcn_sched_barrier(0); }
        const float inv = 1.0f / sum;
        if (!SAMPLE || r < 4) { bf16_t* orow = proj + (row0 + r) * NPROJ + C_MQ + h * 128;
#pragma unroll
            for (int et = 0; et < 8; ++et) { u32x2 w; w.x = pk2(oacc[et][0] * inv, oacc[et][1] * inv); w.y = pk2(oacc[et][2] * inv, oacc[et][3] * inv); *(u32x2*)(orow + 16 * et + 4 * q) = w; } }
    }
    __syncthreads();
}

__device__ __forceinline__ void phase2(LAS unsigned char* lds) {
    const int nb = gridDim.x;
    { KA ap = kargs(); const int bid = obid(); unsigned char* ws = ap->ws; unsigned char* ob = (unsigned char*)ap->out; float* out = ap->out; bf16_t* proj = (bf16_t*)(ws + WS_PROJ);
      for (int item = bid; item < 1024; item += nb)
        gdn_passA(lds, item, proj, (const float*)(ws + WS_AB), ap->in[11], ap->in[12], ap->in[13], (bf16_t*)(ob + OB_UT), (bf16_t*)(ob + OB_W), (bf16_t*)(ws + WS_KGT), (bf16_t*)(ws + WS_QG), (bf16_t*)(ws + WS_AQK),
                  (float*)(ws + WS_GCS), out + O_CVP); }
    { KA ap = kargs(); const int bid = obid(); unsigned char* ws = ap->ws; unsigned char* ob = (unsigned char*)ap->out; bf16_t* proj = (bf16_t*)(ws + WS_PROJ);
      for (int item = bid; item < 1024; item += nb) hg_pass1(lds, item, proj, ap->in[8], (bf16_t*)(ob + OB_DS), (float*)(ws + WS_DEC)); }
}
__device__ __forceinline__ void phase3(LAS unsigned char* lds) {
    KA ap = kargs(); const int bid = obid(), nb = gridDim.x;
    unsigned char* ws = ap->ws; unsigned char* ob = (unsigned char*)ap->out; float* out = ap->out;
    if (bid < 32) {
        gdn_passB(lds, bid, (bf16_t*)(ob + OB_UT), (bf16_t*)(ob + OB_W), (bf16_t*)(ws + WS_KGT), (const float*)(ws + WS_GCS), out + O_GDP);
    } else {
        const int tid = otid();
        { const int per = (65536 + (nb - 32) - 1) / (nb - 32); if (tid < per) { const int task = (bid - 32) * per + tid; if (task < 65536) hg_pass2(task, (bf16_t*)(ob + OB_DS), (const float*)(ws + WS_DEC), out + O_HGP); } }
        bf16_t* proj = (bf16_t*)(ws + WS_PROJ);
        for (int e = bid - 32; e < 1536; e += nb - 32) {
            if (e < 256) hg_sample(lds, e, proj, ap->in[8], ap->in[5], out + O_HGS, ap->in[14], proj);
            else if (e < 512) gdn_sample(lds, e - 256, proj, (const float*)(ws + WS_AB), ap->in[11], ap->in[12], ap->in[13], ap->in[7], out + O_CVS, ap->in[6], out + O_GDS, ap->in[15], proj);
            else if (e < 1024) attn_item<true>(lds, e - 512, proj, nullptr, nullptr, ap->in[3], ap->in[4]);
            else attn_item<false>(lds, e - 1024, proj, (const bf16_t*)(ws + WS_MEMK), (const bf16_t*)(ws + WS_MEMV), nullptr, nullptr);
        }
    }
}
template <int BR> struct EpiMerge {
    static constexpr bool PERM = false;
    float* macc; bf16_t* merged; const bf16_t* proj; bf16_t* merged_s;
    __device__ __forceinline__ void operator()(const f32x4 (&acc)[2][2][4][2], const Unit& u, int wr, int wc, int fr, int fq) const {
        const int row0 = u.pm * 256 + wr * 64 + fr, col0 = u.pn * 256 + wc * 32 + 4 * fq;
#pragma unroll
        for (int ai = 0; ai < 2; ++ai)
#pragma unroll
            for (int m = 0; m < 4; ++m) { const size_t row = (size_t)(row0 + ai * 128 + m * 16);
#pragma unroll
                for (int bj = 0; bj < 2; ++bj)
#pragma unroll
                    for (int n = 0; n < 2; ++n) { const int col = col0 + bj * 128 + n * 16; const u32x2 gz = *(const u32x2*)(proj + row * NPROJ + C_GATE + BR * 1024 + col);
                        f32x4 v; v[0] = sigmoidf_(__uint_as_float(gz.x << 16)) * acc[ai][bj][m][n][0]; v[1] = sigmoidf_(__uint_as_float(gz.x & 0xffff0000u)) * acc[ai][bj][m][n][1];
                        v[2] = sigmoidf_(__uint_as_float(gz.y << 16)) * acc[ai][bj][m][n][2]; v[3] = sigmoidf_(__uint_as_float(gz.y & 0xffff0000u)) * acc[ai][bj][m][n][3];
                        if (BR > 0) v += *(const f32x4*)(macc + row * DM + col);
                        if (BR < 2) *(f32x4*)(macc + row * DM + col) = v;
                        else { u32x2 w; w.x = pg8::cvt_pk_bf16(v[0], v[1]); w.y = pg8::cvt_pk_bf16(v[2], v[3]); *(u32x2*)((row >= MP ? merged_s - (size_t)MP * DM : merged) + row * DM + col) = w; } } }
    }
};
struct EpiOutF32 {
    static constexpr bool PERM = false;
    float* O; float* part;
    __device__ __forceinline__ void operator()(const f32x4 (&acc)[2][2][4][2], const Unit& u, int wr, int wc, int fr, int fq) const {
        const int row0 = u.pm * 256 + wr * 64 + fr, col0 = u.pn * 256 + wc * 32 + 4 * fq;
        float* base = u.tag ? part + ((size_t)(u.tag - 1) * MS - MP) * DM : O;
#pragma unroll
        for (int ai = 0; ai < 2; ++ai)
#pragma unroll
            for (int m = 0; m < 4; ++m) { const size_t row = (size_t)(row0 + ai * 128 + m * 16);
#pragma unroll
                for (int bj = 0; bj < 2; ++bj)
#pragma unroll
                    for (int n = 0; n < 2; ++n) *(f32x4*)(base + row * DM + col0 + bj * 128 + n * 16) = acc[ai][bj][m][n]; }
    }
};
struct EpiSwiGLU {
    static constexpr bool PERM = true;
    bf16_t* O; const float* rs;
    __device__ __forceinline__ void operator()(const f32x4 (&acc)[2][2][4][2], const Unit& u, int wr, int wc, int fr, int fq) const {
        const int row0 = u.pm * 256 + wr * 64 + fr, col0 = u.pn * 128 + wc * 32 + 8 * fq;
#pragma unroll
        for (int ai = 0; ai < 2; ++ai)
#pragma unroll
            for (int m = 0; m < 4; ++m) { const size_t row = (size_t)(row0 + ai * 128 + m * 16); const float r = rs[row]; float o[8];
#pragma unroll
                for (int n = 0; n < 2; ++n)
#pragma unroll
                    for (int j = 0; j < 4; ++j) { const float g = acc[ai][0][m][n][j] * r, up = acc[ai][1][m][n][j] * r; o[n * 4 + j] = siluf_(g) * up; }
                u32x4 w; w.x = pg8::cvt_pk_bf16(o[0], o[1]); w.y = pg8::cvt_pk_bf16(o[2], o[3]); w.z = pg8::cvt_pk_bf16(o[4], o[5]); w.w = pg8::cvt_pk_bf16(o[6], o[7]);
                *(u32x4*)(O + row * FFH + col0) = w; }
    }
};

template <class Sched>
__device__ __forceinline__ void merged_gemms(LAS unsigned char* lds, const Sched& S) {
    KA ap = kargs(); unsigned char* ws = ap->ws; float* macc = ap->out; const bf16_t* proj = (const bf16_t*)(ws + WS_PROJ); bf16_t* merged = (bf16_t*)(ws + WS_MERGED); bf16_t* ms = (bf16_t*)(ws + WS_MRGS);
    { pg8::Gemm g{proj + C_HQ, (const bf16_t*)(ws + WS_WBR), MT, DM, 512, NPROJ, nullptr}; EpiMerge<0> E{macc, merged, proj, ms}; pg8::gemm_phase(lds, g, S, E); }
    { pg8::Gemm g{proj + C_GQKV, (const bf16_t*)(ws + WS_WBR) + (size_t)DM * 512, MT, DM, 512, NPROJ, nullptr}; EpiMerge<1> E{macc, merged, proj, ms}; pg8::gemm_phase(lds, g, S, E); }
    { pg8::Gemm g{proj + C_MQ, (const bf16_t*)(ws + WS_WBR) + (size_t)2 * DM * 512, MT, DM, 512, NPROJ, nullptr}; EpiMerge<2> E{macc, merged, proj, ms}; pg8::gemm_phase(lds, g, S, E); }
}
__device__ __forceinline__ void phase5(LAS unsigned char* lds) {
    pg8::StaticOrder S; S.init(MP, DM, gridDim.x, obid(), 512); merged_gemms(lds, S);
}
__device__ __forceinline__ void phase4(LAS unsigned char* lds) {
    if (obid() < 8) { pg8::SampleOrder S; S.init(512, 8, obid()); merged_gemms(lds, S); return; }
    KA ap = kargs(); const int bid = obid() - 8, nb = gridDim.x - 8;
    unsigned char* ws = ap->ws; unsigned char* ob = (unsigned char*)ap->out;
#if PROBE_DRY & 4
    for (int item = bid; item < 1024; item += nb) gdn_passC(lds, item, (bf16_t*)(ws + WS_PROJ), (const bf16_t*)(ob + OB_UT), (const bf16_t*)(ob + OB_W), (const bf16_t*)(ws + WS_KGT), (const bf16_t*)(ws + WS_QG), (const bf16_t*)(ws + WS_AQK), ap->in[15], C_GQKV + 1024);
#endif
#if PROBE_DRY & 8
    for (int item = bid; item < 1024; item += nb) hg_pass3(lds, item, (bf16_t*)(ws + WS_PROJ), ap->in[8], (const bf16_t*)(ob + OB_DS), ap->in[14], C_GQKV + 512);
#endif
    for (int item = bid; item < 1024; item += nb) gdn_passC(lds, item, (bf16_t*)(ws + WS_PROJ), (const bf16_t*)(ob + OB_UT), (const bf16_t*)(ob + OB_W), (const bf16_t*)(ws + WS_KGT), (const bf16_t*)(ws + WS_QG), (const bf16_t*)(ws + WS_AQK), ap->in[15]);
    for (int item = bid; item < 1024; item += nb) hg_pass3(lds, item, (bf16_t*)(ws + WS_PROJ), ap->in[8], (const bf16_t*)(ob + OB_DS), ap->in[14]);
}

__device__ __forceinline__ void phase6(LAS unsigned char* lds) {
    KA ap = kargs(); unsigned char* ws = ap->ws;
    pg8::Gemm g{(const bf16_t*)(ws + WS_MERGED), (const bf16_t*)(ws + WS_WOUT), MT, DM, DM, DM, (const bf16_t*)(ws + WS_MRGS) - (size_t)MP * DM};
    pg8::TailOrder S; S.init(DM, DM, gridDim.x, obid(), 4); EpiOutF32 E{ap->out, (float*)(ws + WS_PART)}; pg8::gemm_phase(lds, g, S, E);
    { const int bid = obid(), nb = gridDim.x;
      if (bid >= 32) { __syncthreads(); xpose_convert((LAS float*)lds, ap->in[24], 2 * FFH, DM, 2 * FFH, (bf16_t*)(ws + WS_WF1), ap->in[23], 2, bid - 32, nb - 32); } }
}
__device__ __forceinline__ void phase7(LAS unsigned char* lds) {
    KA ap = kargs(); unsigned char* ws = ap->ws; const int bid = obid(), nb = gridDim.x;
    const int tid = otid(), lane = tid & 63, wid = tid >> 6;
    const float* part = (const float*)(ws + WS_PART); const float* gpm = ap->in[22]; float* hbuf = ap->out; bf16_t* hb = (bf16_t*)(ws + WS_HB); float* rh = (float*)(ws + WS_RH);
    const float* x0 = ap->in[0]; const float* x1 = ap->in[1];
    f32x4 gv[4];
#pragma unroll
    for (int i = 0; i < 4; ++i) gv[i] = *(const f32x4*)(gpm + i * 256 + lane * 4);
    const int stride = nb * 8;
    for (int rowb = bid * 8 + wid; rowb < MT; rowb += 2 * stride) {
        f32x4 mv[2][4], xv[2][4]; float sm[2];
#pragma unroll
        for (int u = 0; u < 2; ++u) { const int row = rowb + u * stride; sm[u] = 0.f;
            if (row < MT) { const float* xr = row < MP ? x0 + (size_t)row * DM : x1 + (size_t)(row - MP) * DM;
#pragma unroll
                for (int i = 0; i < 4; ++i) { const int k = i * 256 + lane * 4; xv[u][i] = __builtin_nontemporal_load((const f32x4*)(xr + k));
                    if (row < MP) mv[u][i] = __builtin_nontemporal_load((const f32x4*)(hbuf + (size_t)row * DM + k));
                    else { mv[u][i] = *(const f32x4*)(part + (size_t)(row - MP) * DM + k);
#pragma unroll
                        for (int sp = 1; sp < 4; ++sp) mv[u][i] += *(const f32x4*)(part + ((size_t)sp * MS + (row - MP)) * DM + k); } } } }
#pragma unroll
        for (int u = 0; u < 2; ++u) { const int row = rowb + u * stride;
            if (row < MT) {
#pragma unroll
                for (int i = 0; i < 4; ++i) sm[u] += mv[u][i][0] * mv[u][i][0] + mv[u][i][1] * mv[u][i][1] + mv[u][i][2] * mv[u][i][2] + mv[u][i][3] * mv[u][i][3];
                const float r = rsqrtf(wave_sum(sm[u]) * (1.f / DM) + EPSF); float ss = 0.f;
#pragma unroll
                for (int i = 0; i < 4; ++i) { const int k = i * 256 + lane * 4;
                    const f32x4 hv = xv[u][i] + mv[u][i] * gv[i] * r; ss += hv[0] * hv[0] + hv[1] * hv[1] + hv[2] * hv[2] + hv[3] * hv[3];
                    __builtin_nontemporal_store(hv, (f32x4*)(hbuf + (size_t)row * DM + k)); u32x2 w; w.x = pk2(hv[0], hv[1]); w.y = pk2(hv[2], hv[3]); *(u32x2*)(hb + (size_t)row * DM + k) = w; }
                ss = wave_sum(ss); if (lane == 0) rh[row] = rsqrtf(ss * (1.f / DM) + EPSF); } }
    }
}
__device__ __forceinline__ void phase8(LAS unsigned char* lds) {
    KA ap = kargs(); unsigned char* ws = ap->ws;
    pg8::Gemm g{(const bf16_t*)(ws + WS_HB), (const bf16_t*)(ws + WS_WF1), MT, 2 * FFH, DM, DM, nullptr}; pg8::StaticOrder S; S.init(MT, 2 * FFH, gridDim.x, obid()); EpiSwiGLU E{(bf16_t*)(ws + WS_ACT), (const float*)(ws + WS_RH)}; pg8::gemm_phase(lds, g, S, E);
    { const int nb = gridDim.x, nun = (MT / 256) * (2 * FFH / 256), rem = nun % nb, bid = obid();
      if (rem > 0 && bid >= rem) { __syncthreads(); xpose_convert((LAS float*)lds, ap->in[25], DM, FFH, DM, (bf16_t*)(ws + WS_WF2), nullptr, 0, bid - rem, nb - rem); }
      else if (rem == 0) { __syncthreads(); xpose_convert((LAS float*)lds, ap->in[25], DM, FFH, DM, (bf16_t*)(ws + WS_WF2), nullptr, 0, bid, nb); } }
}
__device__ __forceinline__ void phase9(LAS unsigned char* lds) {
    KA ap = kargs(); unsigned char* ws = ap->ws;
    pg8::Gemm g{(const bf16_t*)(ws + WS_ACT), (const bf16_t*)(ws + WS_WF2), MT, DM, FFH, FFH, (const bf16_t*)(ws + WS_ACT)};
    pg8::TailOrder S; S.init(DM, FFH, gridDim.x, obid(), 11); EpiOutF32 E{(float*)(ws + WS_FF), (float*)(ws + WS_PART)}; pg8::gemm_phase(lds, g, S, E);
}
__device__ __forceinline__ void phase10(LAS unsigned char* lds) {
    KA ap = kargs(); unsigned char* ws = ap->ws; const int bid = obid(), nb = gridDim.x;
    const int tid = otid(), lane = tid & 63, wid = tid >> 6;
    const float* part = (const float*)(ws + WS_PART); const float* gpf = ap->in[26]; float* hbuf = ap->out; const float* ff = (const float*)(ws + WS_FF);
    f32x4 gv[4];
#pragma unroll
    for (int i = 0; i < 4; ++i) gv[i] = *(const f32x4*)(gpf + i * 256 + lane * 4);
    const int stride = nb * 8;
    for (int rowb = bid * 8 + wid; rowb < MT; rowb += 2 * stride) {
        f32x4 fv[2][4], hv[2][4];
#pragma unroll
        for (int u = 0; u < 2; ++u) { const int row = rowb + u * stride;
            if (row < MT) {
#pragma unroll
                for (int i = 0; i < 4; ++i) { const int k = i * 256 + lane * 4; hv[u][i] = __builtin_nontemporal_load((const f32x4*)(hbuf + (size_t)row * DM + k));
                    if (row < MP) fv[u][i] = __builtin_nontemporal_load((const f32x4*)(ff + (size_t)row * DM + k));
                    else { fv[u][i] = *(const f32x4*)(part + (size_t)(row - MP) * DM + k);
#pragma unroll
                        for (int sp = 1; sp < 11; ++sp) fv[u][i] += *(const f32x4*)(part + ((size_t)sp * MS + (row - MP)) * DM + k); } } } }
#pragma unroll
        for (int u = 0; u < 2; ++u) { const int row = rowb + u * stride;
            if (row < MT) { float sm = 0.f;
#pragma unroll
                for (int i = 0; i < 4; ++i) sm += fv[u][i][0] * fv[u][i][0] + fv[u][i][1] * fv[u][i][1] + fv[u][i][2] * fv[u][i][2] + fv[u][i][3] * fv[u][i][3];
                const float r = rsqrtf(wave_sum(sm) * (1.f / DM) + EPSF);
#pragma unroll
                for (int i = 0; i < 4; ++i) { const int k = i * 256 + lane * 4; __builtin_nontemporal_store(hv[u][i] + fv[u][i] * gv[i] * r, (f32x4*)(hbuf + (size_t)row * DM + k)); } } }
    }
}

__global__ void __launch_bounds__(512) fwd_kernel(Args a) {
    extern __shared__ __attribute__((aligned(16))) unsigned char smem_raw[];
    LAS unsigned char* lds = (LAS unsigned char*)smem_raw;
    cg::grid_group grid = cg::this_grid();
    const int ph_lo = kargs()->ph_lo, ph_hi = kargs()->ph_hi;
    volatile LAS unsigned* bst = (volatile LAS unsigned*)(lds + LDS_BYTES - 16);
    if (threadIdx.x == 0) { bst[0] = 0u; bst[1] = 0u; }
    __syncthreads();
    const XcdBarrier xb = xcd_barrier_post((unsigned*)(kargs()->ws + WS_BAR), bst);
    if (ph_hi > 1000) grid.sync();
#define PHASE(k, call) if (ph_lo <= (k) && (k) < ph_hi) { if ((k) > ph_lo) xcd_barrier(xb); call; __syncthreads(); if (PROBE_MASK & (1 << (k))) { call; __syncthreads(); } }
    PHASE(0, phase0(lds))
    PHASE(1, phase1(lds))
    PHASE(2, phase2(lds))
    PHASE(3, phase3(lds))
    PHASE(4, phase4(lds))
    PHASE(5, phase5(lds))
    PHASE(6, phase6(lds))
    PHASE(7, phase7(lds))
    PHASE(8, phase8(lds))
    PHASE(9, phase9(lds))
    PHASE(10, phase10(lds))
#undef PHASE
}

extern "C" void kernel_launch(void* const* d_in, const int* in_sizes, int n_in, void* d_out, int out_size, void* d_ws, size_t ws_size, hipStream_t stream) {
    static int grid = 0;
    if (grid == 0) {
        int dev = 0, cus = 0, per_cu = 0;
        hipGetDevice(&dev);
        hipDeviceGetAttribute(&cus, hipDeviceAttributeMultiprocessorCount, dev);
        if (hipFuncSetAttribute((const void*)fwd_kernel, hipFuncAttributeMaxDynamicSharedMemorySize, LDS_BYTES) != hipSuccess) fprintf(stderr, "hipFuncSetAttribute failed\n");
        hipOccupancyMaxActiveBlocksPerMultiprocessor(&per_cu, (const void*)fwd_kernel, 512, LDS_BYTES);
        if (per_cu < 1) { fprintf(stderr, "occupancy query says %d\n", per_cu); per_cu = 1; }
        grid = cus * 1;
        if (ws_size < WS_END) fprintf(stderr, "workspace too small: %zu < %zu\n", ws_size, (size_t)WS_END);
        if (grid < 64) fprintf(stderr, "grid too small: %d\n", grid);
    }
    hipMemsetAsync((unsigned char*)d_ws + WS_BAR, 0, 16384, stream);
    Args a{};
    for (int i = 0; i < 27; ++i) a.in[i] = (const float*)d_in[i];
    a.out = (float*)d_out; a.ws = (unsigned char*)d_ws; a.ph_lo = 0; a.ph_hi = 12;
    void* args[] = {&a};
    hipError_t e = hipLaunchCooperativeKernel((const void*)fwd_kernel, dim3(grid), dim3(512), args, LDS_BYTES, stream);
    if (e != hipSuccess) fprintf(stderr, "cooperative launch failed: %s (grid %d)\n", hipGetErrorString(e), grid);
}
```

```cpp
#include <hip/hip_runtime.h>
#include <hip/hip_cooperative_groups.h>
#include <cstdio>
#include <cstdint>
namespace cg = cooperative_groups;

#define LAS __attribute__((address_space(3)))
typedef unsigned short bf16_t;
typedef short bf16x8 __attribute__((ext_vector_type(8)));
typedef short bf16x4 __attribute__((ext_vector_type(4)));
typedef float f32x4 __attribute__((ext_vector_type(4)));
typedef float f32x2 __attribute__((ext_vector_type(2)));
typedef unsigned u32x4 __attribute__((ext_vector_type(4)));
typedef unsigned u32x2 __attribute__((ext_vector_type(2)));

constexpr int DM = 1024, MP = 16384, MS = 512, MT = MP + MS, TSEQ = 2048, NB = 8, NBS = 128;
constexpr int NPROJ = 7680, FFH = 2816, INW = 7688;
constexpr int C_HQ = 0, C_HF = 512, C_HI = 1024, C_HG = 1536, C_GQKV = 2048, C_GZ = 3584, C_MQ = 4096, C_GATE = 4608;
constexpr float EPSF = 1e-6f;
constexpr int LDS_BYTES = 147456;
#ifndef PROBE_DRY
#define PROBE_DRY 0
#endif
#ifndef PROBE_MASK
#define PROBE_MASK 0
#endif

constexpr size_t al256(size_t x) { return (x + 255) & ~(size_t)255; }
constexpr size_t WS_WIN = 0;
constexpr size_t WS_WKV = WS_WIN + (size_t)NPROJ * DM * 2;
constexpr size_t WS_WBR = WS_WKV + (size_t)DM * DM * 2;
constexpr size_t WS_WOUT = WS_WBR + (size_t)3 * DM * 512 * 2;
constexpr size_t WS_RX = WS_WOUT + (size_t)DM * DM * 2;
constexpr size_t WS_RMEM = WS_RX + al256((size_t)MT * 4);
constexpr size_t WS_AB = WS_RMEM + al256(2048 * 4);
constexpr size_t WS_DEC = WS_AB + al256((size_t)MT * 8 * 4);
constexpr size_t WS_GCS = WS_DEC + (size_t)1024 * 128 * 4;
constexpr size_t WS_PSS = WS_GCS + al256(1024 * 4);
constexpr size_t WS_RH = WS_PSS + (size_t)MT * 16 * 4;
constexpr size_t WS_MEMB = WS_RH + al256((size_t)MT * 4);
constexpr size_t WS_MEMK = WS_MEMB + (size_t)2048 * 1024 * 2;
constexpr size_t WS_MEMV = WS_MEMK + (size_t)2048 * 512 * 2;
constexpr size_t WS_PROJ = WS_MEMV + (size_t)2048 * 512 * 2;
constexpr size_t WS_G2 = WS_PROJ + (size_t)MT * NPROJ * 2;
constexpr size_t WS_KGT = WS_G2, WS_QG = WS_G2 + 16777216, WS_AQK = WS_G2 + 2 * 16777216;
constexpr size_t WS_MERGED = WS_G2;
constexpr size_t WS_BAR = WS_G2 + 41943040;
constexpr size_t WS_WF1 = WS_BAR + 16384;
constexpr size_t WS_WF2 = WS_WF1 + (size_t)2 * FFH * DM * 2;
constexpr size_t WS_MRGS = WS_WF2 + (size_t)DM * FFH * 2;
constexpr size_t WS_END = WS_MRGS + (size_t)MS * DM * 2;
constexpr size_t WS_HB = WS_PROJ;
constexpr size_t WS_ACT = WS_HB + (size_t)MT * DM * 2;
constexpr size_t WS_FF = WS_ACT + (size_t)MT * FFH * 2;
constexpr size_t WS_PART = WS_FF + (size_t)MT * DM * 4;
static_assert(WS_PART + (size_t)11 * MS * DM * 4 <= WS_G2, "late buffers overflow proj area");
static_assert(WS_END <= 362000000, "workspace too large");
constexpr size_t O_Y = 0, O_MK = 17301504, O_MV = 18350080, O_HGP = 19398656, O_GDP = 19922944, O_CVP = 20447232,
                 O_HGS = 20484096, O_GDS = 28872704, O_CVS = 37261312;
constexpr size_t OB_DS = 0, OB_UT = 33554432, OB_W = OB_UT + 16777216;
constexpr size_t OB_XB = O_HGS * 4;

struct Args {
    const float* in[27];
    float* out;
    unsigned char* ws;
    int ph_lo, ph_hi;
};
typedef const Args __attribute__((address_space(4)))* KA;
__device__ __forceinline__ int otid() { int t = threadIdx.x; asm volatile("" : "+v"(t)); return t; }
__device__ __forceinline__ int obid() { int t = blockIdx.x; asm volatile("" : "+s"(t)); return t; }
__device__ __forceinline__ KA kargs() { KA p = (KA)__builtin_amdgcn_kernarg_segment_ptr(); asm volatile("" : "+s"(p)); return p; }

__device__ __forceinline__ float bf2f(bf16_t b) { return __uint_as_float(((unsigned)b) << 16); }
__device__ __forceinline__ bf16_t f2bf(float f) { unsigned u = __float_as_uint(f); u += 0x7FFFu + ((u >> 16) & 1u); return (bf16_t)(u >> 16); }
__device__ __forceinline__ unsigned pk2(float lo, float hi) { return (unsigned)f2bf(lo) | ((unsigned)f2bf(hi) << 16); }
template <int CTRL> __device__ __forceinline__ float dppf(float v) { return __int_as_float(__builtin_amdgcn_update_dpp(0, __float_as_int(v), CTRL, 0xf, 0xf, true)); }
__device__ __forceinline__ float wave_sum(float v) {
    v += dppf<0xB1>(v);
    v += dppf<0x4E>(v);
    v += dppf<0x141>(v);
    v += dppf<0x140>(v);
    const int vi = __float_as_int(v);
    return (__int_as_float(__builtin_amdgcn_readlane(vi, 0)) + __int_as_float(__builtin_amdgcn_readlane(vi, 16))) + (__int_as_float(__builtin_amdgcn_readlane(vi, 32)) + __int_as_float(__builtin_amdgcn_readlane(vi, 48)));
}
__device__ __forceinline__ float sigmoidf_(float x) { return __builtin_amdgcn_rcpf(1.0f + __expf(-x)); }
__device__ __forceinline__ float siluf_(float x) { return x * __builtin_amdgcn_rcpf(1.0f + __expf(-x)); }
__device__ __forceinline__ f32x4 mfma16(bf16x8 a, bf16x8 b, f32x4 c) { return __builtin_amdgcn_mfma_f32_16x16x32_bf16(a, b, c, 0, 0, 0); }


#define XB_TMO      128
#define XB_XCNT(j)  (256  + 64 * (j))
#define XB_XSUB(j)  (1280 + 64 * (j))
#define XB_XGEN(j)  (2304 + 64 * (j))
#define XB_TOP      3328
#define XB_TOPGEN   3392
#define XCD_BAR_WORDS 3456
#define XB_SPIN_CAP (1u << 18)
__device__ __forceinline__ unsigned xb_ld(unsigned* p)              { return __hip_atomic_load(p, __ATOMIC_RELAXED, __HIP_MEMORY_SCOPE_AGENT); }
__device__ __forceinline__ unsigned xb_add(unsigned* p, unsigned v) { return __hip_atomic_fetch_add(p, v, __ATOMIC_RELAXED, __HIP_MEMORY_SCOPE_AGENT); }
__device__ __forceinline__ unsigned xb_xcc_id() { return (unsigned)__builtin_amdgcn_s_getreg((3 << 11) | 20) & 0xFu; }
#define XB_SPIN(cond, bar) do { unsigned _sp = 0; while (cond) { __builtin_amdgcn_s_sleep(1); \
    if ((++_sp & 255u) == 0u) { if (xb_ld(&(bar)[XB_TMO])) break; if (_sp > XB_SPIN_CAP) { atomicAdd(&(bar)[XB_TMO], 1u); break; } } } } while (0)
struct XcdBarrier { unsigned* bar; unsigned x; volatile LAS unsigned* st; };
__device__ __forceinline__ XcdBarrier xcd_barrier_post(unsigned* bar, volatile LAS unsigned* st) {
    XcdBarrier b; b.bar = bar; b.x = xb_xcc_id(); b.st = st;
    if (threadIdx.x == 0) (void)xb_add(&bar[XB_XCNT(b.x)], 1u);
    return b;
}
__device__ __forceinline__ void xcd_barrier_complete(unsigned* bar, unsigned x, unsigned& nloc, unsigned& nx) {
    const unsigned G = gridDim.x * gridDim.y * gridDim.z;
    unsigned sum, cnt, mine, sp = 0u;
    for (;;) {
        sum = 0u; cnt = 0u; mine = 0u;
#pragma unroll
        for (unsigned j = 0; j < 16; ++j) { const unsigned c = xb_ld(&bar[XB_XCNT(j)]); sum += c; cnt += (c > 0u) ? 1u : 0u; mine = (j == x) ? c : mine; }
        if (sum == G) break;
        __builtin_amdgcn_s_sleep(1);
        if ((++sp & 255u) == 0u) { if (xb_ld(&bar[XB_TMO])) break; if (sp > XB_SPIN_CAP) { atomicAdd(&bar[XB_TMO], 1u); break; } }
    }
    nloc = mine > 0u ? mine : 1u; nx = cnt > 0u ? cnt : 1u;
}
__device__ __forceinline__ void xcd_barrier(const XcdBarrier& b) {
    asm volatile("s_waitcnt vmcnt(0)" ::: "memory");
    __syncthreads();
    if (threadIdx.x == 0) {
        unsigned* bar = b.bar;
        __builtin_amdgcn_s_waitcnt(0);
        unsigned nloc = b.st[0], nx = b.st[1];
        if (nloc == 0u) { xcd_barrier_complete(bar, b.x, nloc, nx); b.st[0] = nloc; b.st[1] = nx; }
        const unsigned old = xb_add(&bar[XB_XSUB(b.x)], 1u);
        const unsigned gen = old / nloc;
        if (old + 1u == (gen + 1u) * nloc) {
            __builtin_amdgcn_fence(__ATOMIC_RELEASE, "agent");
            asm volatile("s_waitcnt vmcnt(0)" ::: "memory");
            const unsigned og = xb_add(&bar[XB_TOP], 1u);
            const unsigned tg = og / nx;
            if (og + 1u == (tg + 1u) * nx) xb_add(&bar[XB_TOPGEN], 1u);
            else XB_SPIN(xb_ld(&bar[XB_TOPGEN]) == tg, bar);
            __builtin_amdgcn_fence(__ATOMIC_ACQUIRE, "agent");
            xb_add(&bar[XB_XGEN(b.x)], 1u);
            asm volatile("s_waitcnt vmcnt(0)" ::: "memory");
        } else {
            XB_SPIN(xb_ld(&bar[XB_XGEN(b.x)]) == gen, bar);
            __builtin_amdgcn_fence(__ATOMIC_ACQUIRE, "agent");
            asm volatile("s_waitcnt vmcnt(0)" ::: "memory");
        }
    }
    __syncthreads();
}

namespace pg8 {
constexpr int BM = 256, BK = 64, HALF = 128, HTB = HALF * BK * 2, STAGE_BYTES = 8 * HTB, NXCD = 8, WGM = 4;
__host__ __device__ __forceinline__ int lds_byte(int r, int c) { const int st = (r >> 4) * 2 + (c >> 5), rr = r & 15, cc = c & 31, ob = rr * 64 + cc * 2; return st * 1024 + (ob ^ (((ob >> 9) & 1) << 5)); }
__host__ __device__ __forceinline__ void stage_rc(int b, int& R, int& C) { const int st = b / 1024, sb = b % 1024, swz = sb ^ (((sb >> 9) & 1) << 5); R = (st >> 1) * 16 + swz / 64; C = (st & 1) * 32 + (swz % 64) / 2; }
__host__ __device__ __forceinline__ int perm32(int rho) { const int n = rho >> 4, i = rho & 15; return 8 * (i >> 2) + 4 * n + (i & 3); }
struct Unit { int pm, pn, koff, nt, tag; };
struct Gemm { const bf16_t* A; const bf16_t* Bt; int M, N, K, lda; const bf16_t* A2; };
struct StaticOrder {
    int nM, nN, nwg, G, c;
    __device__ void init(int M, int N, int G_, int c_, int K = 1024) { nM = M / BM; nN = N / BM; nwg = nM * nN; G = G_; c = c_; ntk = K / BK; }
    __device__ bool next(int i, Unit& u) const {
        const long L = (long)i * G + c; if (L >= nwg) return false;
        int wgid = (int)L; { const int q = nwg / NXCD, r = nwg % NXCD, xcd = wgid % NXCD, off = wgid / NXCD; wgid = (xcd < r ? xcd * (q + 1) : r * (q + 1) + (xcd - r) * q) + off; }
        const int nig = WGM * nN, gid = wgid / nig, fm = gid * WGM, gsz = (nM - fm) < WGM ? (nM - fm) : WGM;
        u.pm = fm + ((wgid % nig) % gsz); u.pn = (wgid % nig) / gsz; u.koff = 0; u.nt = ntk; u.tag = 0; return true;
    }
    int ntk;
};
struct TailOrder {
    StaticOrder base; int nsplit, njobs;
    __device__ void init(int N, int K, int G_, int c_, int nsplit_) { base.init(MP, N, G_, c_, K); nsplit = nsplit_; njobs = 8 * nsplit_; }
    __device__ bool next(int i, Unit& u) const {
        const int np = (base.nwg - base.c + base.G - 1) / base.G;
        if (i < np) return base.next(i, u);
        const int L = (i - np) * base.G + base.c; if (L >= njobs) return false;
        const int ks = L % nsplit, un = L / nsplit; u.pm = 64 + (un >> 2); u.pn = un & 3; u.koff = ks * 256; u.nt = 4; u.tag = 1 + ks; return true;
    }
};
struct SampleOrder {
    int G, c, ntk;
    __device__ void init(int K, int G_, int c_) { G = G_; c = c_; ntk = K / BK; }
    __device__ bool next(int i, Unit& u) const { const int L = i * G + c; if (L >= 8) return false; u.pm = 64 + (L >> 2); u.pn = L & 3; u.koff = 0; u.nt = ntk; u.tag = 0; return true; }
};
__device__ __forceinline__ unsigned cvt_pk_bf16(float lo, float hi) { unsigned r; asm volatile("v_cvt_pk_bf16_f32 %0, %1, %2" : "=v"(r) : "v"(lo), "v"(hi)); return r; }

template <class Epi, class Sched>
__device__ __forceinline__ void gemm_phase(LAS unsigned char* lds, const Gemm g, const Sched& S, const Epi& E) {
    int tid_ = threadIdx.x; asm volatile("" : "+v"(tid_));
    const int tid = tid_, wid = __builtin_amdgcn_readfirstlane(tid >> 6), lane = tid & 63, wr = wid >> 2, wc = wid & 3, fr = lane & 15, fq = lane >> 4;
    const int K = g.K, lda = g.lda;
    unsigned voffA[2], voffB[2];
#pragma unroll
    for (int i = 0; i < 2; ++i) { int R, C; stage_rc(tid * 16 + i * 8192, R, C); const int Rb = Epi::PERM ? ((R & ~31) + perm32(R & 31)) : R;
        voffA[i] = (unsigned)(R * lda + C) * 2u; voffB[i] = (unsigned)(Rb * K + C) * 2u; }
    const size_t kstep = (size_t)(BK * 2);
    const size_t hstepA = (size_t)HALF * lda * 2, hstepB = (size_t)HALF * K * 2;
    const size_t tstepA = 2 * hstepA, tstepB = 2 * hstepB;
    const unsigned ldsw = (unsigned)wid * 1024u;
    const int aoff = lds_byte(wr * 64 + fr, fq * 8), boff = lds_byte(wc * 32 + fr, fq * 8);
#define PG8_SA(b, h) (((b) * 2 + (h)) * HTB)
#define PG8_SB(b, h) ((4 + (b) * 2 + (h)) * HTB)
#define PG8_STAGE(bufoff, gbase, voff) do { _Pragma("unroll") for (int _i = 0; _i < 2; ++_i) \
        __builtin_amdgcn_global_load_lds((const unsigned*)((const char*)(gbase) + (voff)[_i]), (LAS unsigned*)(lds + (bufoff) + ldsw + _i * 8192), 16, 0, 0); } while (0)
#define PG8_LDA(dst, b, h) do { _Pragma("unroll") for (int m = 0; m < 4; ++m) _Pragma("unroll") for (int k = 0; k < 2; ++k) dst[m][k] = *(const LAS bf16x8*)(lds + PG8_SA(b, h) + aoff + m * 2048 + k * 1024); } while (0)
#define PG8_LDB(dst, b, h) do { _Pragma("unroll") for (int n = 0; n < 2; ++n) _Pragma("unroll") for (int k = 0; k < 2; ++k) dst[n][k] = *(const LAS bf16x8*)(lds + PG8_SB(b, h) + boff + n * 2048 + k * 1024); } while (0)
#define PG8_MMA(ai, bj, At, Bt) do { __builtin_amdgcn_s_setprio(1); _Pragma("unroll") for (int m = 0; m < 4; ++m) _Pragma("unroll") for (int n = 0; n < 2; ++n) _Pragma("unroll") for (int k = 0; k < 2; ++k) \
        acc[ai][bj][m][n] = __builtin_amdgcn_mfma_f32_16x16x32_bf16(Bt[n][k], At[m][k], acc[ai][bj][m][n], 0, 0, 0); __builtin_amdgcn_s_setprio(0); } while (0)
#define PG8_WAIT_V(n) asm volatile("s_waitcnt vmcnt(" #n ")" ::: "memory")
#define PG8_WAIT_L(n) asm volatile("s_waitcnt lgkmcnt(" #n ")" ::: "memory")
#define PG8_BAR __builtin_amdgcn_s_barrier()
#define PG8_SCHED __builtin_amdgcn_sched_barrier(0)
    Unit cur, nxt; int ui = 0;
    if (!S.next(0, cur)) return;
    f32x4 acc[2][2][4][2];
#pragma unroll
    for (int a = 0; a < 2; ++a)
#pragma unroll
        for (int b = 0; b < 2; ++b)
#pragma unroll
            for (int m = 0; m < 4; ++m)
#pragma unroll
                for (int n = 0; n < 2; ++n) acc[a][b][m][n] = (f32x4){0.f, 0.f, 0.f, 0.f};
    bf16x8 At[4][2], B0[2][2], B1[2][2];
    const char* cA = (const char*)(cur.tag ? g.A2 : g.A) + (size_t)cur.pm * tstepA + (size_t)cur.koff * 2; const char* cB = (const char*)g.Bt + (size_t)cur.pn * tstepB + (size_t)cur.koff * 2;
    PG8_STAGE(PG8_SB(0, 0), cB, voffB); PG8_STAGE(PG8_SB(0, 1), cB + hstepB, voffB); PG8_STAGE(PG8_SA(0, 0), cA, voffA); PG8_STAGE(PG8_SA(0, 1), cA + hstepA, voffA);
    if (wr == 1) PG8_BAR;
    PG8_WAIT_V(2); PG8_BAR;
    PG8_STAGE(PG8_SB(1, 0), cB + kstep, voffB); PG8_STAGE(PG8_SA(1, 0), cA + kstep, voffA); PG8_STAGE(PG8_SB(1, 1), cB + hstepB + kstep, voffB);
    PG8_WAIT_V(6); PG8_BAR;
    for (;;) {
        const bool has_next = S.next(ui + 1, nxt);
        const char* nA = has_next ? (const char*)(nxt.tag ? g.A2 : g.A) + (size_t)nxt.pm * tstepA + (size_t)nxt.koff * 2 : cA; const char* nB = has_next ? (const char*)g.Bt + (size_t)nxt.pn * tstepB + (size_t)nxt.koff * 2 : cB;
        const int nt = cur.nt;
        for (int t = 0; t < nt; t += 2) {
            const bool last = (t == nt - 2);
            const char* a1 = cA + (size_t)(t + 1) * kstep;
            const char* a2 = last ? nA : cA + (size_t)(t + 2) * kstep; const char* b2 = last ? nB : cB + (size_t)(t + 2) * kstep;
            const char* a3 = a2 + kstep; const char* b3 = b2 + kstep;
            PG8_LDB(B0, 0, 0); PG8_LDB(B1, 0, 1); PG8_SCHED; PG8_LDA(At, 0, 0); PG8_STAGE(PG8_SA(1, 1), a1 + hstepA, voffA);
            PG8_WAIT_V(8); PG8_WAIT_L(0); PG8_BAR; PG8_MMA(0, 0, At, B0); PG8_MMA(0, 1, At, B1); PG8_BAR; PG8_SCHED;
            PG8_LDA(At, 0, 1); PG8_STAGE(PG8_SB(0, 0), b2, voffB); PG8_STAGE(PG8_SB(0, 1), b2 + hstepB, voffB); PG8_STAGE(PG8_SA(0, 0), a2, voffA);
            PG8_WAIT_V(8); PG8_WAIT_L(0); PG8_BAR; PG8_MMA(1, 0, At, B0); PG8_MMA(1, 1, At, B1); PG8_BAR; PG8_SCHED;
            PG8_LDB(B0, 1, 0); PG8_LDB(B1, 1, 1); PG8_SCHED; PG8_LDA(At, 1, 0); PG8_STAGE(PG8_SA(0, 1), a2 + hstepA, voffA);
            PG8_WAIT_V(8); PG8_WAIT_L(0); PG8_BAR; PG8_MMA(0, 0, At, B0); PG8_MMA(0, 1, At, B1); PG8_BAR; PG8_SCHED;
            PG8_LDA(At, 1, 1); PG8_STAGE(PG8_SB(1, 0), b3, voffB); PG8_STAGE(PG8_SB(1, 1), b3 + hstepB, voffB); PG8_STAGE(PG8_SA(1, 0), a3, voffA);
            PG8_WAIT_V(8); PG8_WAIT_L(0); PG8_BAR; PG8_MMA(1, 0, At, B0); PG8_MMA(1, 1, At, B1); PG8_BAR; PG8_SCHED;
        }
        if (wr == 0) PG8_BAR;
        E(acc, cur, wr, wc, fr, fq);
        if (!has_next) break;
#pragma unroll
        for (int a = 0; a < 2; ++a)
#pragma unroll
            for (int b = 0; b < 2; ++b)
#pragma unroll
                for (int m = 0; m < 4; ++m)
#pragma unroll
                    for (int n = 0; n < 2; ++n) acc[a][b][m][n] = (f32x4){0.f, 0.f, 0.f, 0.f};
        cur = nxt; cA = nA; cB = nB; ++ui;
        if (wr == 1) PG8_BAR;
    }
    PG8_WAIT_V(0);
    PG8_BAR;
#undef PG8_SA
#undef PG8_SB
#undef PG8_STAGE
#undef PG8_LDA
#undef PG8_LDB
#undef PG8_MMA
#undef PG8_WAIT_V
#undef PG8_WAIT_L
#undef PG8_BAR
#undef PG8_SCHED
}
}
using pg8::Unit;

struct EpiProj {
    static constexpr bool PERM = true;
    bf16_t* O; const float* rs;
    __device__ __forceinline__ void operator()(const f32x4 (&acc)[2][2][4][2], const Unit& u, int wr, int wc, int fr, int fq) const {
        const int row0 = u.pm * 256 + wr * 64 + fr, col0 = u.pn * 256 + wc * 32 + 8 * fq;
#pragma unroll
        for (int ai = 0; ai < 2; ++ai)
#pragma unroll
            for (int m = 0; m < 4; ++m) { const int row = row0 + ai * 128 + m * 16; const float r = rs[row]; bf16_t* rowp = O + (size_t)row * NPROJ + col0;
#pragma unroll
                for (int bj = 0; bj < 2; ++bj) { const f32x4 v0 = acc[ai][bj][m][0] * r, v1 = acc[ai][bj][m][1] * r;
                    u32x4 w; w.x = pg8::cvt_pk_bf16(v0[0], v0[1]); w.y = pg8::cvt_pk_bf16(v0[2], v0[3]); w.z = pg8::cvt_pk_bf16(v1[0], v1[1]); w.w = pg8::cvt_pk_bf16(v1[2], v1[3]);
                    *(u32x4*)(rowp + bj * 128) = w; } }
    }
};
struct EpiKV {
    static constexpr bool PERM = false;
    float* ok; float* ov; bf16_t* bk; bf16_t* bv; const float* rs;
    __device__ __forceinline__ void operator()(const f32x4 (&acc)[2][2][4][2], const Unit& u, int wr, int wc, int fr, int fq) const {
        const int row0 = u.pm * 256 + wr * 64 + fr; const int isv = u.pn >> 1; const int colt = (u.pn & 1) * 256 + wc * 32 + 4 * fq;
        float* of = isv ? ov : ok; bf16_t* ob = isv ? bv : bk;
#pragma unroll
        for (int ai = 0; ai < 2; ++ai)
#pragma unroll
            for (int m = 0; m < 4; ++m) { const int row = row0 + ai * 128 + m * 16; const float r = rs[row];
#pragma unroll
                for (int bj = 0; bj < 2; ++bj)
#pragma unroll
                    for (int n = 0; n < 2; ++n) { const f32x4 v = acc[ai][bj][m][n] * r; const int col = colt + bj * 128 + n * 16;
                        *(f32x4*)(of + (size_t)row * 512 + col) = v;
                        u32x2 w; w.x = pg8::cvt_pk_bf16(v[0], v[1]); w.y = pg8::cvt_pk_bf16(v[2], v[3]); *(u32x2*)(ob + (size_t)row * 512 + col) = w; } }
    }
};

__device__ __forceinline__ void xpose_convert(LAS float* tile, const float* __restrict__ src, int ldsrc, int K, int N, bf16_t* __restrict__ dst, const float* __restrict__ scale, int mode, int bid, int nb) {
    const int tid = otid(); const int nkt = K / 64, ntile = nkt * (N / 64);
    float cur[8];
    auto tile_src = [&](int t, int& k0, int& n0) -> int { const int kt = t % nkt, nti = t / nkt; k0 = kt * 64; n0 = nti * 64; int sc0 = n0;
        if (mode == 1) sc0 = n0 < 4096 ? n0 : n0 + 8;
        else if (mode == 2) { const int pn = n0 >> 8, bj = (n0 >> 7) & 1, i = n0 & 127; sc0 = bj * FFH + pn * 128 + i; }
        return sc0; };
    auto load_tile = [&](int t, float (&v)[8]) { int k0, n0; const int sc0 = tile_src(t, k0, n0);
#pragma unroll
        for (int i = 0; i < 8; ++i) { const int idx = tid + i * 512, r = idx >> 6, c = idx & 63; float x = src[(size_t)(k0 + r) * ldsrc + sc0 + c]; if (scale) x *= scale[k0 + r]; v[i] = x; } };
    int t = bid;
    if (t < ntile) load_tile(t, cur);
    for (; t < ntile; t += nb) {
        int k0, n0; (void)tile_src(t, k0, n0);
#pragma unroll
        for (int i = 0; i < 8; ++i) { const int idx = tid + i * 512, r = idx >> 6, c = idx & 63; tile[r * 65 + c] = cur[i]; }
        __syncthreads();
        if (t + nb < ntile) load_tile(t + nb, cur);
        { const int n = tid >> 3, kk = (tid & 7) * 8; u32x4 o;
          o.x = pk2(tile[(kk + 0) * 65 + n], tile[(kk + 1) * 65 + n]); o.y = pk2(tile[(kk + 2) * 65 + n], tile[(kk + 3) * 65 + n]);
          o.z = pk2(tile[(kk + 4) * 65 + n], tile[(kk + 5) * 65 + n]); o.w = pk2(tile[(kk + 6) * 65 + n], tile[(kk + 7) * 65 + n]);
          *(u32x4*)(dst + (size_t)(n0 + n) * K + k0 + kk) = o; }
        __syncthreads();
    }
}

__device__ __forceinline__ void phase0(LAS unsigned char* lds) {
    KA ap = kargs();
    struct { const float* in[27]; float* out; unsigned char* ws; } a; a.out = ap->out; a.ws = ap->ws;
    a.in[0] = ap->in[0]; a.in[1] = ap->in[1]; a.in[2] = ap->in[2]; a.in[9] = ap->in[9]; a.in[10] = ap->in[10]; a.in[16] = ap->in[16]; a.in[17] = ap->in[17]; a.in[18] = ap->in[18]; a.in[19] = ap->in[19]; a.in[20] = ap->in[20]; a.in[21] = ap->in[21];
    const int tid = otid(), lane = tid & 63, wid = tid >> 6, bid = obid(), nb = gridDim.x;
    unsigned char* ws = a.ws;
    LAS float* tile = (LAS float*)lds;
    xpose_convert(tile, a.in[10], INW, DM, NPROJ, (bf16_t*)(ws + WS_WIN), a.in[9], 1, bid, nb);
    xpose_convert(tile, a.in[17], DM, DM, DM, (bf16_t*)(ws + WS_WKV), a.in[16], 0, bid, nb);
    xpose_convert(tile, a.in[18], DM, 512, DM, (bf16_t*)(ws + WS_WBR), nullptr, 0, bid, nb);
    xpose_convert(tile, a.in[19], DM, 512, DM, (bf16_t*)(ws + WS_WBR) + (size_t)DM * 512, nullptr, 0, bid, nb);
    xpose_convert(tile, a.in[20], DM, 512, DM, (bf16_t*)(ws + WS_WBR) + (size_t)2 * DM * 512, nullptr, 0, bid, nb);
    xpose_convert(tile, a.in[21], DM, DM, DM, (bf16_t*)(ws + WS_WOUT), nullptr, 0, bid, nb);
    LAS float* wab = (LAS float*)lds;
    for (int i = tid; i < 8192; i += 512) { const int k = i >> 3, j = i & 7; wab[i] = a.in[9][k] * a.in[10][(size_t)k * INW + 4096 + j]; }
    __syncthreads();
    bf16_t* xb = (bf16_t*)((unsigned char*)a.out + OB_XB); bf16_t* memb = (bf16_t*)(ws + WS_MEMB);
    float* rx = (float*)(ws + WS_RX); float* rmem = (float*)(ws + WS_RMEM); float* ab = (float*)(ws + WS_AB);
    const int stride = nb * 8;
    for (int rowb = bid * 8 + wid; rowb < MT + 2048; rowb += 2 * stride) {
        f32x4 v[2][4];
#pragma unroll
        for (int u = 0; u < 2; ++u) { const int row = rowb + u * stride;
            if (row < MT + 2048) { const float* src = row < MP ? a.in[0] + (size_t)row * DM : (row < MT ? a.in[1] + (size_t)(row - MP) * DM : a.in[2] + (size_t)(row - MT) * DM);
#pragma unroll
                for (int i = 0; i < 4; ++i) v[u][i] = __builtin_nontemporal_load((const f32x4*)(src + i * 256 + lane * 4)); } }
#pragma unroll
        for (int u = 0; u < 2; ++u) { const int row = rowb + u * stride;
            if (row < MT + 2048) {
                bf16_t* dst = row < MT ? xb + (size_t)row * DM : memb + (size_t)(row - MT) * DM;
                float ss = 0.f; float dots[8];
#pragma unroll
                for (int j = 0; j < 8; ++j) dots[j] = 0.f;
#pragma unroll
                for (int i = 0; i < 4; ++i) { const int k = i * 256 + lane * 4; const f32x4 vv = v[u][i];
                    ss += vv[0] * vv[0] + vv[1] * vv[1] + vv[2] * vv[2] + vv[3] * vv[3];
                    u32x2 w; w.x = pk2(vv[0], vv[1]); w.y = pk2(vv[2], vv[3]); *(u32x2*)(dst + k) = w;
                    if (row < MT) {
#pragma unroll
                        for (int e = 0; e < 4; ++e) { const f32x4 w0 = *(const LAS f32x4*)(wab + (k + e) * 8), w1 = *(const LAS f32x4*)(wab + (k + e) * 8 + 4);
                            dots[0] += vv[e] * w0[0]; dots[1] += vv[e] * w0[1]; dots[2] += vv[e] * w0[2]; dots[3] += vv[e] * w0[3];
                            dots[4] += vv[e] * w1[0]; dots[5] += vv[e] * w1[1]; dots[6] += vv[e] * w1[2]; dots[7] += vv[e] * w1[3]; } } }
                ss = wave_sum(ss);
                const float r = rsqrtf(ss * (1.0f / DM) + EPSF);
                if (row < MT) {
#pragma unroll
                    for (int j = 0; j < 8; ++j) dots[j] = wave_sum(dots[j]);
                    if (lane == 0) { rx[row] = r;
#pragma unroll
                        for (int j = 0; j < 8; ++j) ab[(size_t)row * 8 + j] = dots[j] * r; }
                } else if (lane == 0) rmem[row - MT] = r; } }
    }
}

__device__ __forceinline__ void phase1(LAS unsigned char* lds) {
    KA ap = kargs();
    struct { float* out; unsigned char* ws; } a; a.out = ap->out; a.ws = ap->ws;
    unsigned char* ws = a.ws;
    { pg8::Gemm g{(const bf16_t*)((unsigned char*)a.out + OB_XB), (const bf16_t*)(ws + WS_WIN), MT, NPROJ, DM, DM, nullptr};
      pg8::StaticOrder S; S.init(MT, NPROJ, gridDim.x, obid());
      EpiProj E{(bf16_t*)(ws + WS_PROJ), (const float*)(ws + WS_RX)};
      pg8::gemm_phase(lds, g, S, E); }
    { pg8::Gemm g{(const bf16_t*)(ws + WS_MEMB), (const bf16_t*)(ws + WS_WKV), 2048, DM, DM, DM, nullptr};
      pg8::StaticOrder S; S.init(2048, DM, gridDim.x, gridDim.x - 1 - obid());
      EpiKV E{a.out + O_MK, a.out + O_MV, (bf16_t*)(ws + WS_MEMK), (bf16_t*)(ws + WS_MEMV), (const float*)(ws + WS_RMEM)};
      pg8::gemm_phase(lds, g, S, E); }
}

__device__ __forceinline__ float lb_of(const float* lbl, int ch) { return 1.0f / (1.0f + __expf(lbl[512 + ch] - lbl[ch])); }
__device__ __forceinline__ float softplusf_(float x) { return x > 20.f ? x : log1pf(__expf(x)); }
__device__ __forceinline__ bf16x8 ld2x4(const LAS bf16_t* p0, const LAS bf16_t* p1) {
    const bf16x4 a = *(const LAS bf16x4*)p0, b = *(const LAS bf16x4*)p1; bf16x8 r;
    r[0] = a[0]; r[1] = a[1]; r[2] = a[2]; r[3] = a[3]; r[4] = b[0]; r[5] = b[1]; r[6] = b[2]; r[7] = b[3]; return r;
}
__device__ __forceinline__ bf16x8 pkfrag(const f32x4 a, const f32x4 b) {
    u32x4 w; w.x = pk2(a[0], a[1]); w.y = pk2(a[2], a[3]); w.z = pk2(b[0], b[1]); w.w = pk2(b[2], b[3]); return *(bf16x8*)&w;
}

__device__ __forceinline__ void hg_pass1(LAS unsigned char* lds, int item, const bf16_t* proj, const float* lbl, bf16_t* dS, float* dec) {
    const int tid = otid(), lane = tid & 63, wid = tid >> 6, r = lane & 15, q = lane >> 4;
    const int d = tid & 127, seg = tid >> 7;
    const int c = item & 31, bh = item >> 5, h = bh & 3, b = bh >> 2;
    LAS bf16_t* KT = (LAS bf16_t*)lds;
    LAS bf16_t* VT = KT + 128 * 72;
    LAS float* tot = (LAS float*)(VT + 128 * 72);
    LAS bf16_t* SW = (LAS bf16_t*)(tot + 512) + wid * (16 * 136);
    const size_t row0 = (size_t)b * TSEQ + c * 64 + seg * 16;
    const bf16_t* pf = proj + row0 * NPROJ + C_HF + h * 128 + d;
    const bf16_t* pv = proj + row0 * NPROJ + C_HI + h * 128 + d;
    const float lb = lb_of(lbl, h * 128 + d);
    float Lc[16], kk[16]; float run = 0.f; unsigned vp[8];
#pragma unroll
    for (int i = 0; i < 16; ++i) { const float fz = bf2f(pf[(size_t)i * NPROJ]); const float f = lb + (1.f - lb) * sigmoidf_(fz); run += __logf(f); Lc[i] = run; kk[i] = 1.f - f; }
#pragma unroll
    for (int i = 0; i < 8; ++i) vp[i] = (unsigned)pv[(size_t)(2 * i) * NPROJ] | ((unsigned)pv[(size_t)(2 * i + 1) * NPROJ] << 16);
    tot[seg * 128 + d] = run;
    __syncthreads();
    const float t0 = tot[d], t1 = tot[128 + d], t2 = tot[256 + d], t3 = tot[384 + d];
    const float rem = (seg < 1 ? t1 : 0.f) + (seg < 2 ? t2 : 0.f) + (seg < 3 ? t3 : 0.f);
    unsigned kp[8];
#pragma unroll
    for (int i = 0; i < 8; ++i) { const float a0 = kk[2 * i] * __expf((run - Lc[2 * i]) + rem), a1 = kk[2 * i + 1] * __expf((run - Lc[2 * i + 1]) + rem); kp[i] = pk2(a0, a1); }
    *(LAS u32x4*)(KT + d * 72 + seg * 16) = (u32x4){kp[0], kp[1], kp[2], kp[3]}; *(LAS u32x4*)(KT + d * 72 + seg * 16 + 8) = (u32x4){kp[4], kp[5], kp[6], kp[7]};
    *(LAS u32x4*)(VT + d * 72 + seg * 16) = (u32x4){vp[0], vp[1], vp[2], vp[3]}; *(LAS u32x4*)(VT + d * 72 + seg * 16 + 8) = (u32x4){vp[4], vp[5], vp[6], vp[7]};
    if (seg == 0) dec[(size_t)item * 128 + d] = __expf(t0 + t1 + t2 + t3);
    __syncthreads();
    bf16_t* out = dS + (size_t)item * 16384;
#pragma unroll
    for (int n = 0; n < 8; ++n) { f32x4 acc = {0.f, 0.f, 0.f, 0.f};
#pragma unroll
        for (int ks = 0; ks < 2; ++ks) { const bf16x8 X = *(const LAS bf16x8*)(KT + (16 * n + r) * 72 + ks * 32 + q * 8), Y = *(const LAS bf16x8*)(VT + (16 * wid + r) * 72 + ks * 32 + q * 8); acc = mfma16(X, Y, acc); }
        u32x2 w; w.x = pk2(acc[0], acc[1]); w.y = pk2(acc[2], acc[3]); *(LAS u32x2*)(SW + r * 136 + 16 * n + 4 * q) = w; }
#pragma unroll
    for (int i = 0; i < 4; ++i) { const int id = lane + 64 * i, rw = id >> 4, c16 = id & 15; *(u32x4*)(out + (16 * wid + rw) * 128 + c16 * 8) = *(const LAS u32x4*)(SW + rw * 136 + c16 * 8); }
    __syncthreads();
}

__device__ __forceinline__ void hg_pass2(int task, bf16_t* dS, const float* dec, float* out_state) {
    const int bh = task >> 11, e = (task >> 4) & 127, d0 = (task & 15) * 8;
    float S[8];
#pragma unroll
    for (int j = 0; j < 8; ++j) S[j] = 0.f;
#pragma unroll 1
    for (int c8 = 0; c8 < 32; c8 += 8) {
        u32x4 raw[8]; f32x4 dc0[8], dc1[8];
#pragma unroll
        for (int i = 0; i < 8; ++i) { const size_t item = (size_t)bh * 32 + c8 + i; raw[i] = *(const u32x4*)(dS + (item * 128 + e) * 128 + d0);
            dc0[i] = *(const f32x4*)(dec + item * 128 + d0); dc1[i] = *(const f32x4*)(dec + item * 128 + d0 + 4); }
#pragma unroll
        for (int i = 0; i < 8; ++i) { const size_t item = (size_t)bh * 32 + c8 + i;
            u32x4 w; w.x = pk2(S[0], S[1]); w.y = pk2(S[2], S[3]); w.z = pk2(S[4], S[5]); w.w = pk2(S[6], S[7]); *(u32x4*)(dS + (item * 128 + e) * 128 + d0) = w;
            S[0] = dc0[i][0] * S[0] + __uint_as_float(raw[i].x << 16); S[1] = dc0[i][1] * S[1] + __uint_as_float(raw[i].x & 0xffff0000u);
            S[2] = dc0[i][2] * S[2] + __uint_as_float(raw[i].y << 16); S[3] = dc0[i][3] * S[3] + __uint_as_float(raw[i].y & 0xffff0000u);
            S[4] = dc1[i][0] * S[4] + __uint_as_float(raw[i].z << 16); S[5] = dc1[i][1] * S[5] + __uint_as_float(raw[i].z & 0xffff0000u);
            S[6] = dc1[i][2] * S[6] + __uint_as_float(raw[i].w << 16); S[7] = dc1[i][3] * S[7] + __uint_as_float(raw[i].w & 0xffff0000u); }
    }
#pragma unroll
    for (int j = 0; j < 8; ++j) out_state[((size_t)bh * 128 + d0 + j) * 128 + e] = S[j];
}

__device__ __forceinline__ void hg_pass3(LAS unsigned char* lds, int item, bf16_t* proj, const float* lbl, const bf16_t* SinT, const float* g_out, int ocol = C_HQ) {
    const int tid = otid(), lane = tid & 63, wid = tid >> 6, r = lane & 15, q = lane >> 4;
    const int d = tid & 127, seg = tid >> 7;
    const int c = item & 31, bh = item >> 5, h = bh & 3, b = bh >> 2;
    LAS bf16_t* QT = (LAS bf16_t*)lds;
    LAS bf16_t* QG = QT + 64 * 136;
    LAS bf16_t* KTB = QG + 64 * 136;
    LAS bf16_t* VT = KTB + 10 * 16 * 136;
    LAS bf16_t* AS = VT + 128 * 72;
    LAS float* tot = (LAS float*)(AS + 64 * 72);
    LAS float* ssq = tot + 512;
    const size_t row0 = (size_t)b * TSEQ + c * 64 + seg * 16;
    {
        const bf16_t* pq = proj + row0 * NPROJ + C_HQ + h * 128 + d;
        const bf16_t* pf = proj + row0 * NPROJ + C_HF + h * 128 + d;
        const bf16_t* pv = proj + row0 * NPROJ + C_HI + h * 128 + d;
        const float lb = lb_of(lbl, h * 128 + d);
        float Lc[16], kk[16], qq[16]; float run = 0.f; unsigned vp[8];
#pragma unroll
        for (int i = 0; i < 16; ++i) { const float fz = bf2f(pf[(size_t)i * NPROJ]); const float f = lb + (1.f - lb) * sigmoidf_(fz); run += __logf(f); Lc[i] = run; kk[i] = 1.f - f; qq[i] = bf2f(pq[(size_t)i * NPROJ]); }
#pragma unroll
        for (int i = 0; i < 8; ++i) vp[i] = (unsigned)pv[(size_t)(2 * i) * NPROJ] | ((unsigned)pv[(size_t)(2 * i + 1) * NPROJ] << 16);
        tot[seg * 128 + d] = run;
        __syncthreads();
        const float t0 = tot[d], t1 = tot[128 + d], t2 = tot[256 + d];
        const float R = (seg > 0 ? t0 : 0.f) + (seg > 1 ? t1 : 0.f) + (seg > 2 ? t2 : 0.f);
        const float eR = __expf(R);
        const int tri_d = seg * (seg + 1) / 2 + seg;
#pragma unroll
        for (int i = 0; i < 16; ++i) { const float qt = qq[i] * __expf(Lc[i]); const int t = seg * 16 + i;
            QT[t * 136 + d] = f2bf(qt); QG[t * 136 + d] = f2bf(qt * eR);
            KTB[(tri_d * 16 + i) * 136 + d] = f2bf(kk[i] * __expf(fminf(-Lc[i], 80.f))); }
        for (int ii = seg + 1; ii < 4; ++ii) { float mid = 0.f; if (seg < 1 && ii > 1) mid += t1; if (seg < 2 && ii > 2) mid += t2;
            const int tri = ii * (ii + 1) / 2 + seg;
#pragma unroll
            for (int i = 0; i < 16; ++i) KTB[(tri * 16 + i) * 136 + d] = f2bf(kk[i] * __expf((run - Lc[i]) + mid)); }
        *(LAS u32x4*)(VT + d * 72 + seg * 16) = (u32x4){vp[0], vp[1], vp[2], vp[3]}; *(LAS u32x4*)(VT + d * 72 + seg * 16 + 8) = (u32x4){vp[4], vp[5], vp[6], vp[7]};
    }
    __syncthreads();
#pragma unroll
    for (int rep = 0; rep < 2; ++rep) { const int blk = wid + rep * 8, bi = blk >> 2, bj = blk & 3; f32x4 acc = {0.f, 0.f, 0.f, 0.f};
        if (bj <= bi) { const int tri = bi * (bi + 1) / 2 + bj;
#pragma unroll
            for (int ks = 0; ks < 4; ++ks) { const bf16x8 X = *(const LAS bf16x8*)(KTB + (tri * 16 + r) * 136 + ks * 32 + q * 8), Y = *(const LAS bf16x8*)(QT + (16 * bi + r) * 136 + ks * 32 + q * 8); acc = mfma16(X, Y, acc); }
            if (bi == bj) {
#pragma unroll
                for (int jj = 0; jj < 4; ++jj) if (4 * q + jj > r) acc[jj] = 0.f; } }
        u32x2 w; w.x = pk2(acc[0], acc[1]); w.y = pk2(acc[2], acc[3]); *(LAS u32x2*)(AS + (16 * bi + r) * 72 + 16 * bj + 4 * q) = w; }
    __syncthreads();
    const int ti = wid & 3, eh = wid >> 2;
    f32x4 acc[4];
#pragma unroll
    for (int nn = 0; nn < 4; ++nn) { const int n = eh * 4 + nn; acc[nn] = (f32x4){0.f, 0.f, 0.f, 0.f};
#pragma unroll
        for (int ks = 0; ks < 2; ++ks) { const bf16x8 X = *(const LAS bf16x8*)(VT + (16 * n + r) * 72 + ks * 32 + q * 8), Y = *(const LAS bf16x8*)(AS + (16 * ti + r) * 72 + ks * 32 + q * 8); acc[nn] = mfma16(X, Y, acc[nn]); }
#pragma unroll
        for (int ks = 0; ks < 4; ++ks) { const bf16x8 X = *(const bf16x8*)(SinT + ((size_t)item * 128 + 16 * n + r) * 128 + ks * 32 + q * 8), Y = *(const LAS bf16x8*)(QG + (16 * ti + r) * 136 + ks * 32 + q * 8); acc[nn] = mfma16(X, Y, acc[nn]); } __builtin_amdgcn_sched_barrier(0); }
    float pss = 0.f;
#pragma unroll
    for (int nn = 0; nn < 4; ++nn) pss += acc[nn][0] * acc[nn][0] + acc[nn][1] * acc[nn][1] + acc[nn][2] * acc[nn][2] + acc[nn][3] * acc[nn][3];
    pss += __shfl_xor(pss, 16); pss += __shfl_xor(pss, 32);
    if (q == 0) ssq[(16 * ti + r) * 2 + eh] = pss;
    __syncthreads();
    { const int t = 16 * ti + r; const float rinv = rsqrtf((ssq[t * 2] + ssq[t * 2 + 1]) * (1.f / 128.f) + EPSF);
      bf16_t* prow = proj + ((size_t)b * TSEQ + c * 64 + t) * NPROJ;
#pragma unroll
      for (int nn = 0; nn < 4; ++nn) { const int e0 = 16 * (eh * 4 + nn) + 4 * q; const u32x2 gz = *(const u32x2*)(prow + C_HG + h * 128 + e0); const f32x4 gg = *(const f32x4*)(g_out + h * 128 + e0);
          const float v0 = acc[nn][0] * rinv * gg[0] * siluf_(__uint_as_float(gz.x << 16)), v1 = acc[nn][1] * rinv * gg[1] * siluf_(__uint_as_float(gz.x & 0xffff0000u));
          const float v2 = acc[nn][2] * rinv * gg[2] * siluf_(__uint_as_float(gz.y << 16)), v3 = acc[nn][3] * rinv * gg[3] * siluf_(__uint_as_float(gz.y & 0xffff0000u));
          u32x2 w; w.x = pk2(v0, v1); w.y = pk2(v2, v3); *(LAS u32x2*)(QT + t * 136 + e0) = w; } }
    __syncthreads();
#pragma unroll
    for (int i = 0; i < 2; ++i) { const int id = tid + 512 * i, rw = id >> 4, c16 = id & 15;
        *(u32x4*)(proj + ((size_t)b * TSEQ + c * 64 + rw) * NPROJ + ocol + h * 128 + c16 * 8) = *(const LAS u32x4*)(QT + rw * 136 + c16 * 8); }
    __syncthreads();
}

__device__ __forceinline__ void gdn_passA(LAS unsigned char* lds, int item, const bf16_t* proj, const float* ab, const float* wconv, const float* a_log, const float* dt_bias,
                                          bf16_t* uT, bf16_t* wo, bf16_t* kgT, bf16_t* qg, bf16_t* aqk, float* gcs, float* conv_out) {
    const int tid = otid(), lane = tid & 63, wid = tid >> 6, r = lane & 15, q = lane >> 4;
    const int c = item & 31, bh = item >> 5, h = bh & 3, b = bh >> 2;
    LAS bf16_t* Qb = (LAS bf16_t*)lds;
    LAS bf16_t* Kb = Qb + 64 * 136;
    LAS float* KF = (LAS float*)(Kb + 64 * 136);
    LAS float* VF = KF + 64 * 132;
    LAS float* Msm = VF + 64 * 132;
    LAS float* gl = Msm + 64 * 68;
    LAS float* be = gl + 64;
    LAS float* Gs = be + 64;
    LAS float* WC = Gs + 64;
    { const int nbw = (int)gridDim.x; const bool restage = (item < nbw) || ((((item - nbw) >> 5) & 3) != h);
      if (restage) { const int tid0 = otid(); for (int i = tid0; i < 1536; i += 512) { const int grp = i >> 9, j = (i >> 7) & 3, dd = i & 127; WC[i] = wconv[j * 1536 + grp * 512 + h * 128 + dd]; }
        __syncthreads(); } }
    {
        const int t = tid >> 3, dg = tid & 7, d0 = dg * 16;
        const int tg = c * 64 + t; const size_t row = (size_t)b * TSEQ + tg;
#pragma unroll
        for (int grp = 0; grp < 3; ++grp) { const int ch0 = grp * 512 + h * 128 + d0; float o[16];
#pragma unroll
            for (int i = 0; i < 16; ++i) o[i] = 0.f;
            u32x4 raw[4][2]; float msk[4];
#pragma unroll
            for (int j = 0; j < 4; ++j) { const bool ok = (tg - 3 + j >= 0); msk[j] = ok ? 1.f : 0.f; const bf16_t* pr = proj + (ok ? row - 3 + j : row) * NPROJ + C_GQKV + ch0;
                raw[j][0] = *(const u32x4*)pr; raw[j][1] = *(const u32x4*)(pr + 8); }
#pragma unroll
            for (int j = 0; j < 4; ++j) { const u32x4 u0 = raw[j][0], u1 = raw[j][1];
                    const unsigned uu[8] = {u0.x, u0.y, u0.z, u0.w, u1.x, u1.y, u1.z, u1.w};
#pragma unroll
                    for (int i = 0; i < 8; ++i) { const f32x2 wv = *(const LAS f32x2*)(WC + (grp * 4 + j) * 128 + d0 + 2 * i) * msk[j]; const float lo = __uint_as_float(uu[i] << 16), hi = __uint_as_float(uu[i] & 0xffff0000u);
                        o[2 * i] += wv[0] * lo; o[2 * i + 1] += wv[1] * hi; }
                    asm volatile("" : "+v"(o[0]), "+v"(o[1]), "+v"(o[14]), "+v"(o[15]) :: "memory"); }
            asm volatile("" ::: "memory");
            if (c == 31 && t >= 61) {
                const bf16_t* pr = proj + row * NPROJ + C_GQKV + ch0; const u32x4 u0 = *(const u32x4*)pr, u1 = *(const u32x4*)(pr + 8); const unsigned uu[8] = {u0.x, u0.y, u0.z, u0.w, u1.x, u1.y, u1.z, u1.w};
#pragma unroll
                for (int i = 0; i < 8; ++i) { conv_out[((size_t)b * 3 + (t - 61)) * 1536 + ch0 + 2 * i] = __uint_as_float(uu[i] << 16); conv_out[((size_t)b * 3 + (t - 61)) * 1536 + ch0 + 2 * i + 1] = __uint_as_float(uu[i] & 0xffff0000u); } }
#pragma unroll
            for (int i = 0; i < 16; ++i) o[i] = siluf_(o[i]);
            if (grp < 2) {
                float sq = 0.f;
#pragma unroll
                for (int i = 0; i < 16; ++i) sq += o[i] * o[i];
                sq += __shfl_xor(sq, 1); sq += __shfl_xor(sq, 2); sq += __shfl_xor(sq, 4);
                const float rn = rsqrtf(sq + EPSF) * (grp == 0 ? 0.08838834764831845f : 1.0f);
                unsigned pp[8];
#pragma unroll
                for (int i = 0; i < 16; ++i) o[i] *= rn;
#pragma unroll
                for (int i = 0; i < 8; ++i) pp[i] = pk2(o[2 * i], o[2 * i + 1]);
                LAS bf16_t* dstb = (grp == 0 ? Qb : Kb) + t * 136 + d0;
                *(LAS u32x4*)dstb = (u32x4){pp[0], pp[1], pp[2], pp[3]}; *(LAS u32x4*)(dstb + 8) = (u32x4){pp[4], pp[5], pp[6], pp[7]};
                if (grp == 1) {
#pragma unroll
                    for (int i = 0; i < 4; ++i) *(LAS f32x4*)(KF + t * 132 + d0 + 4 * i) = (f32x4){o[4 * i], o[4 * i + 1], o[4 * i + 2], o[4 * i + 3]}; }
            } else {
#pragma unroll
                for (int i = 0; i < 4; ++i) *(LAS f32x4*)(VF + t * 132 + d0 + 4 * i) = (f32x4){o[4 * i], o[4 * i + 1], o[4 * i + 2], o[4 * i + 3]}; }
            asm volatile("" ::: "memory"); }
        if (dg == 0) { KA ap2 = kargs(); const float* ab2 = (const float*)(ap2->ws + WS_AB); const float ar = ab2[row * 8 + h], br = ab2[row * 8 + 4 + h]; be[t] = sigmoidf_(br); gl[t] = -__expf(ap2->in[12][h]) * softplusf_(ar + ap2->in[13][h]); }
    }
    __syncthreads();
    { float g = gl[lane];
#pragma unroll
        for (int o = 1; o < 64; o <<= 1) { const float v = __shfl_up(g, o); if (lane >= o) g += v; }
        Gs[lane] = g; }
    {
        const int ti = wid >> 1; const int t = 16 * ti + r; const float Gt = Gs[t], bet = be[t];
#pragma unroll
        for (int sx = 0; sx < 2; ++sx) { const int sj = (wid & 1) * 2 + sx; f32x4 aK = {0.f, 0.f, 0.f, 0.f}, aQ = {0.f, 0.f, 0.f, 0.f};
            if (sj <= ti) {
#pragma unroll
                for (int ks = 0; ks < 4; ++ks) { const bf16x8 X = *(const LAS bf16x8*)(Kb + (16 * sj + r) * 136 + ks * 32 + q * 8);
                    const bf16x8 Y1 = *(const LAS bf16x8*)(Kb + (16 * ti + r) * 136 + ks * 32 + q * 8), Y2 = *(const LAS bf16x8*)(Qb + (16 * ti + r) * 136 + ks * 32 + q * 8);
                    aK = mfma16(X, Y1, aK); aQ = mfma16(X, Y2, aQ); } }
            f32x4 mv, av;
#pragma unroll
            for (int jj = 0; jj < 4; ++jj) { const int s = 16 * sj + 4 * q + jj; const float dcy = (s <= t) ? __expf(Gt - Gs[s]) : 0.f; mv[jj] = (s < t) ? bet * dcy * aK[jj] : 0.f; av[jj] = dcy * aQ[jj]; }
            *(LAS f32x4*)(Msm + t * 68 + 16 * sj + 4 * q) = mv;
            u32x2 w; w.x = pk2(av[0], av[1]); w.y = pk2(av[2], av[3]); *(u32x2*)(aqk + (size_t)item * 4096 + t * 64 + 16 * sj + 4 * q) = w; }
    }
    __syncthreads();
    const float GC = Gs[63];
    if (tid < 256) {
        const int col = tid; float X[64];
        const LAS float* rsrc = (col < 128) ? VF + col : KF + (col - 128);
#pragma unroll
        for (int blk = 0; blk < 4; ++blk) { float a[16];
#pragma unroll
            for (int rr = 0; rr < 16; ++rr) { const int t = 16 * blk + rr; a[rr] = rsrc[t * 132] * be[t] * (col < 128 ? 1.f : __expf(Gs[t])); }
#pragma unroll
            for (int s4 = 0; s4 < 16 * blk; s4 += 4) {
#pragma unroll
                for (int rr = 0; rr < 16; ++rr) { const f32x4 m = *(const LAS f32x4*)(Msm + (16 * blk + rr) * 68 + s4);
                    a[rr] -= m[0] * X[s4]; a[rr] -= m[1] * X[s4 + 1]; a[rr] -= m[2] * X[s4 + 2]; a[rr] -= m[3] * X[s4 + 3]; }
                asm volatile("" ::: "memory"); }
#pragma unroll
            for (int rr = 0; rr < 16; ++rr) { const int t = 16 * blk + rr; float av = a[rr];
#pragma unroll
                for (int s4 = 16 * blk; s4 < t; s4 += 4) { const f32x4 m = *(const LAS f32x4*)(Msm + t * 68 + s4);
#pragma unroll
                    for (int jj = 0; jj < 4; ++jj) if (s4 + jj < t) av -= m[jj] * X[s4 + jj]; }
                asm volatile("" : "+v"(av) :: "memory"); X[t] = av; } }
        if (col < 128) { bf16_t* dst = uT + (size_t)item * 8192 + col * 64;
#pragma unroll
            for (int i = 0; i < 8; ++i) { u32x4 w; w.x = pk2(X[8 * i], X[8 * i + 1]); w.y = pk2(X[8 * i + 2], X[8 * i + 3]); w.z = pk2(X[8 * i + 4], X[8 * i + 5]); w.w = pk2(X[8 * i + 6], X[8 * i + 7]); *(u32x4*)(dst + 8 * i) = w; } }
        else { bf16_t* dst = wo + (size_t)item * 8192 + (col - 128);
#pragma unroll
            for (int t = 0; t < 64; ++t) dst[t * 128] = f2bf(X[t]); }
    } else {
        const int tt = tid - 256;
#pragma unroll
        for (int i = 0; i < 4; ++i) { const int ch = tt + i * 256, t = ch >> 4, d8 = (ch & 15) * 8; const u32x4 raw = *(const LAS u32x4*)(Qb + t * 136 + d8); const float eg = __expf(Gs[t]);
            u32x4 w; w.x = pk2(__uint_as_float(raw.x << 16) * eg, __uint_as_float(raw.x & 0xffff0000u) * eg); w.y = pk2(__uint_as_float(raw.y << 16) * eg, __uint_as_float(raw.y & 0xffff0000u) * eg);
            w.z = pk2(__uint_as_float(raw.z << 16) * eg, __uint_as_float(raw.z & 0xffff0000u) * eg); w.w = pk2(__uint_as_float(raw.w << 16) * eg, __uint_as_float(raw.w & 0xffff0000u) * eg);
            *(u32x4*)(qg + (size_t)item * 8192 + t * 128 + d8) = w; }
        { const int d = tt & 127, hf = tt >> 7; bf16_t* dst = kgT + (size_t)item * 8192 + d * 64 + hf * 32;
#pragma unroll
          for (int i = 0; i < 4; ++i) { float v[8];
#pragma unroll
              for (int j = 0; j < 8; ++j) { const int t = hf * 32 + i * 8 + j; v[j] = KF[t * 132 + d] * __expf(GC - Gs[t]); }
              u32x4 w; w.x = pk2(v[0], v[1]); w.y = pk2(v[2], v[3]); w.z = pk2(v[4], v[5]); w.w = pk2(v[6], v[7]); *(u32x4*)(dst + i * 8) = w; } }
        if (tt == 0) gcs[item] = __expf(GC);
    }
    __syncthreads();
}

__device__ __forceinline__ void gdn_passB(LAS unsigned char* lds, int bh, bf16_t* uT, bf16_t* wo, bf16_t* kgT, const float* gcs, float* out_state) {
    const int tid = otid(), lane = tid & 63, wid = tid >> 6, r = lane & 15, q = lane >> 4;
    const int e0 = 16 * wid;
    constexpr int BUF = 64 * 136 + 128 * 72;
    LAS bf16_t* L0 = (LAS bf16_t*)lds;
    LAS bf16_t* SW = L0 + 2 * BUF + wid * (16 * 136 + 16 * 72);
    LAS bf16_t* VW = SW + 16 * 136;
    u32x4 pw[2][2], pk[2][2]; u32x2 pu[2][4];
    const int rw0 = tid >> 4, cw = (tid & 15) * 8;
    const int rk0 = tid >> 3, ck = (tid & 7) * 8;
#define GB_LOAD(S_, item_) do { const size_t it_ = (size_t)(item_); \
        pw[S_][0] = *(const u32x4*)(wo + it_ * 8192 + rw0 * 128 + cw); pw[S_][1] = *(const u32x4*)(wo + it_ * 8192 + (rw0 + 32) * 128 + cw); \
        pk[S_][0] = *(const u32x4*)(kgT + it_ * 8192 + rk0 * 64 + ck); pk[S_][1] = *(const u32x4*)(kgT + it_ * 8192 + (rk0 + 64) * 64 + ck); \
        _Pragma("unroll") for (int ti_ = 0; ti_ < 4; ++ti_) pu[S_][ti_] = *(const u32x2*)(uT + it_ * 8192 + (e0 + r) * 64 + 16 * ti_ + 4 * q); } while (0)
#define GB_STORE(S_, buf_) do { LAS bf16_t* W_ = L0 + (buf_) * BUF; LAS bf16_t* K_ = W_ + 64 * 136; \
        *(LAS u32x4*)(W_ + rw0 * 136 + cw) = pw[S_][0]; *(LAS u32x4*)(W_ + (rw0 + 32) * 136 + cw) = pw[S_][1]; \
        *(LAS u32x4*)(K_ + rk0 * 72 + ck) = pk[S_][0]; *(LAS u32x4*)(K_ + (rk0 + 64) * 72 + ck) = pk[S_][1]; } while (0)
    const float gcl = (lane < 32) ? gcs[bh * 32 + lane] : 0.f;
    u32x2 ucur[4], unext[4];
    GB_LOAD(0, bh * 32);
    GB_LOAD(1, bh * 32 + 1);
    GB_STORE(0, 0);
#pragma unroll
    for (int ti = 0; ti < 4; ++ti) ucur[ti] = pu[0][ti];
    GB_LOAD(0, bh * 32 + 2);
    f32x4 Sacc[8];
#pragma unroll
    for (int i = 0; i < 8; ++i) Sacc[i] = (f32x4){0.f, 0.f, 0.f, 0.f};
    asm volatile("s_waitcnt lgkmcnt(0)" ::: "memory"); __builtin_amdgcn_s_barrier(); asm volatile("" ::: "memory");
#define GB_STEP(c_, S1_) do { const int c = (c_); const size_t item = (size_t)bh * 32 + c; \
        const LAS bf16_t* W = L0 + (c & 1) * BUF; const LAS bf16_t* KGT = W + 64 * 136; \
        if (c < 31) { GB_STORE(S1_, (c + 1) & 1); _Pragma("unroll") for (int ti = 0; ti < 4; ++ti) unext[ti] = pu[S1_][ti]; if (c < 29) GB_LOAD(S1_, item + 3); } \
        const float gc = __shfl(gcl, c); \
        bf16x8 Sf[4]; \
        _Pragma("unroll") for (int ks = 0; ks < 4; ++ks) Sf[ks] = pkfrag(Sacc[2 * ks], Sacc[2 * ks + 1]); \
        { _Pragma("unroll") for (int ks = 0; ks < 4; ++ks) { const u32x4 raw = *(const u32x4*)&Sf[ks]; *(LAS u32x2*)(SW + r * 136 + 32 * ks + 4 * q) = (u32x2){raw.x, raw.y}; *(LAS u32x2*)(SW + r * 136 + 32 * ks + 16 + 4 * q) = (u32x2){raw.z, raw.w}; } \
          bf16_t* dst = (wid < 4 ? wo + item * 8192 + e0 * 128 : kgT + item * 8192 + (e0 - 64) * 128); \
          _Pragma("unroll") for (int i = 0; i < 4; ++i) { const int id = lane + 64 * i, rw = id >> 4, c16 = id & 15; *(u32x4*)(dst + rw * 128 + c16 * 8) = *(const LAS u32x4*)(SW + rw * 136 + c16 * 8); } } \
        f32x4 P[4]; \
        _Pragma("unroll") for (int ti = 0; ti < 4; ++ti) P[ti] = (f32x4){0.f, 0.f, 0.f, 0.f}; \
        _Pragma("unroll") for (int ks = 0; ks < 4; ++ks) \
            _Pragma("unroll") for (int ti = 0; ti < 4; ++ti) { const LAS bf16_t* pwp = W + (16 * ti + r) * 136 + 32 * ks + 4 * q; P[ti] = mfma16(ld2x4(pwp, pwp + 16), Sf[ks], P[ti]); } \
        f32x4 vn[4]; \
        _Pragma("unroll") for (int ti = 0; ti < 4; ++ti) { const u32x2 uu = ucur[ti]; \
            vn[ti][0] = __uint_as_float(uu.x << 16) - P[ti][0]; vn[ti][1] = __uint_as_float(uu.x & 0xffff0000u) - P[ti][1]; \
            vn[ti][2] = __uint_as_float(uu.y << 16) - P[ti][2]; vn[ti][3] = __uint_as_float(uu.y & 0xffff0000u) - P[ti][3]; \
            u32x2 w; w.x = pk2(vn[ti][0], vn[ti][1]); w.y = pk2(vn[ti][2], vn[ti][3]); *(LAS u32x2*)(VW + r * 72 + 16 * ti + 4 * q) = w; } \
        { bf16_t* dstv = uT + item * 8192 + e0 * 64; \
          _Pragma("unroll") for (int i = 0; i < 2; ++i) { const int id = lane + 64 * i, rw = id >> 3, c8 = id & 7; *(u32x4*)(dstv + rw * 64 + c8 * 8) = *(const LAS u32x4*)(VW + rw * 72 + c8 * 8); } } \
        bf16x8 Vf[2]; \
        Vf[0] = pkfrag(vn[0], vn[1]); Vf[1] = pkfrag(vn[2], vn[3]); \
        _Pragma("unroll") for (int dt = 0; dt < 8; ++dt) Sacc[dt] = Sacc[dt] * gc; \
        _Pragma("unroll") for (int k2 = 0; k2 < 2; ++k2) \
            _Pragma("unroll") for (int dt = 0; dt < 8; ++dt) { const LAS bf16_t* pp = KGT + (16 * dt + r) * 72 + 32 * k2 + 4 * q; Sacc[dt] = mfma16(ld2x4(pp, pp + 16), Vf[k2], Sacc[dt]); } \
        _Pragma("unroll") for (int ti = 0; ti < 4; ++ti) ucur[ti] = unext[ti]; \
        asm volatile("s_waitcnt lgkmcnt(0)" ::: "memory"); __builtin_amdgcn_s_barrier(); asm volatile("" ::: "memory"); } while (0)
#pragma unroll 1
    for (int c2 = 0; c2 < 32; c2 += 2) { GB_STEP(c2, 1); GB_STEP(c2 + 1, 0); }
#undef GB_STEP
#undef GB_LOAD
#undef GB_STORE
#pragma unroll
    for (int dt = 0; dt < 8; ++dt)
#pragma unroll
        for (int jj = 0; jj < 4; ++jj) out_state[((size_t)bh * 128 + 16 * dt + 4 * q + jj) * 128 + e0 + r] = Sacc[dt][jj];
    __syncthreads();
}
__device__ __forceinline__ void gdn_passC(LAS unsigned char* lds, int item, bf16_t* proj, const bf16_t* vnT, const bf16_t* st_lo, const bf16_t* st_hi, const bf16_t* qg, const bf16_t* aqk, const float* g_out, int ocol = C_GQKV) {
    const int tid = otid(), lane = tid & 63, wid = tid >> 6, r = lane & 15, q = lane >> 4;
    const int c = item & 31, bh = item >> 5, h = bh & 3, b = bh >> 2;
    LAS float* ssq = (LAS float*)lds;
    LAS bf16_t* OT = (LAS bf16_t*)(lds + 1024);
    const int ti = wid & 3, eh = wid >> 2;
    const bf16_t* ST = (eh == 0 ? st_lo : st_hi) + (size_t)item * 8192;
    bf16x8 Yq[4], Ya[2];
#pragma unroll
    for (int ks = 0; ks < 4; ++ks) Yq[ks] = *(const bf16x8*)(qg + (size_t)item * 8192 + (16 * ti + r) * 128 + ks * 32 + q * 8);
#pragma unroll
    for (int ks = 0; ks < 2; ++ks) Ya[ks] = *(const bf16x8*)(aqk + (size_t)item * 4096 + (16 * ti + r) * 64 + ks * 32 + q * 8);
    f32x4 acc[4];
#pragma unroll
    for (int nn = 0; nn < 4; ++nn) { const int n = eh * 4 + nn; acc[nn] = (f32x4){0.f, 0.f, 0.f, 0.f};
#pragma unroll
        for (int ks = 0; ks < 4; ++ks) { const bf16x8 X = *(const bf16x8*)(ST + (16 * nn + r) * 128 + ks * 32 + q * 8); acc[nn] = mfma16(X, Yq[ks], acc[nn]); }
#pragma unroll
        for (int ks = 0; ks < 2; ++ks) { const bf16x8 X = *(const bf16x8*)(vnT + (size_t)item * 8192 + (16 * n + r) * 64 + ks * 32 + q * 8); acc[nn] = mfma16(X, Ya[ks], acc[nn]); } }
    float pss = 0.f;
#pragma unroll
    for (int nn = 0; nn < 4; ++nn) pss += acc[nn][0] * acc[nn][0] + acc[nn][1] * acc[nn][1] + acc[nn][2] * acc[nn][2] + acc[nn][3] * acc[nn][3];
    pss += __shfl_xor(pss, 16); pss += __shfl_xor(pss, 32);
    if (q == 0) ssq[(16 * ti + r) * 2 + eh] = pss;
    __syncthreads();
    { const int t = 16 * ti + r; const float rinv = rsqrtf((ssq[t * 2] + ssq[t * 2 + 1]) * (1.f / 128.f) + EPSF);
      bf16_t* prow = proj + ((size_t)b * TSEQ + c * 64 + t) * NPROJ;
#pragma unroll
      for (int nn = 0; nn < 4; ++nn) { const int e0 = 16 * (eh * 4 + nn) + 4 * q; const u32x2 gz = *(const u32x2*)(prow + C_GZ + h * 128 + e0); const f32x4 gg = *(const f32x4*)(g_out + e0);
          const float v0 = acc[nn][0] * rinv * gg[0] * siluf_(__uint_as_float(gz.x << 16)), v1 = acc[nn][1] * rinv * gg[1] * siluf_(__uint_as_float(gz.x & 0xffff0000u));
          const float v2 = acc[nn][2] * rinv * gg[2] * siluf_(__uint_as_float(gz.y << 16)), v3 = acc[nn][3] * rinv * gg[3] * siluf_(__uint_as_float(gz.y & 0xffff0000u));
          u32x2 w; w.x = pk2(v0, v1); w.y = pk2(v2, v3); *(LAS u32x2*)(OT + t * 136 + e0) = w; } }
    __syncthreads();
#pragma unroll
    for (int i = 0; i < 2; ++i) { const int id = tid + 512 * i, rw = id >> 4, c16 = id & 15;
        *(u32x4*)(proj + ((size_t)b * TSEQ + c * 64 + rw) * NPROJ + ocol + h * 128 + c16 * 8) = *(const LAS u32x4*)(OT + rw * 136 + c16 * 8); }
    __syncthreads();
}

__device__ __forceinline__ void hg_sample(LAS unsigned char* lds, int it, bf16_t* proj, const float* lbl, const float* st_in, float* st_out, const float* g_out, bf16_t* oproj) {
    const int tid = otid(), lane = tid & 63, wid = tid >> 6, sub = tid >> 8, hf = (tid >> 7) & 1, e = tid & 127;
    const int bh = it * 2 + sub, b = bh >> 2, h = bh & 3;
    LAS float* qs = (LAS float*)lds; LAS float* fs = qs + 1024; LAS float* ks = fs + 1024; LAS float* red = ks + 1024; LAS float* po = red + 64;
    float v[4], gt[4];
    { const float lb = lb_of(lbl, h * 128 + e);
#pragma unroll
      for (int t = 0; t < 4; ++t) { const bf16_t* pr = proj + ((size_t)MP + b * 4 + t) * NPROJ + h * 128 + e; const float f = lb + (1.f - lb) * sigmoidf_(bf2f(pr[C_HF]));
          if (hf == 0) { qs[(sub * 4 + t) * 128 + e] = bf2f(pr[C_HQ]); fs[(sub * 4 + t) * 128 + e] = f; ks[(sub * 4 + t) * 128 + e] = 1.f - f; }
          v[t] = bf2f(pr[C_HI]); gt[t] = bf2f(pr[C_HG]); } }
    __syncthreads();
    float S[64]; const float* sp = st_in + (size_t)bh * 16384 + (size_t)hf * 8192 + e;
#pragma unroll
    for (int d8 = 0; d8 < 64; d8 += 8) {
#pragma unroll
        for (int j = 0; j < 8; ++j) S[d8 + j] = __builtin_nontemporal_load(sp + j * 128);
        sp += 1024; asm volatile("" ::: "memory"); }
    float ot[4];
#pragma unroll
    for (int t = 0; t < 4; ++t) { float o = 0.f; asm volatile("" ::: "memory"); const LAS float* fq = fs + (sub * 4 + t) * 128 + hf * 64; const LAS float* kq = ks + (sub * 4 + t) * 128 + hf * 64; const LAS float* qq = qs + (sub * 4 + t) * 128 + hf * 64;
#pragma unroll
        for (int d4 = 0; d4 < 64; d4 += 4) { const f32x4 f4 = *(const LAS f32x4*)(fq + d4), k4 = *(const LAS f32x4*)(kq + d4), q4 = *(const LAS f32x4*)(qq + d4);
#pragma unroll
            for (int j = 0; j < 4; ++j) { S[d4 + j] = f4[j] * S[d4 + j] + k4[j] * v[t]; o += q4[j] * S[d4 + j]; }
            asm volatile("" : "+v"(S[d4]), "+v"(S[d4 + 1]), "+v"(S[d4 + 2]), "+v"(S[d4 + 3]), "+v"(o) :: "memory"); }
        ot[t] = o; }
    float* op = st_out + (size_t)bh * 16384 + (size_t)hf * 8192 + e;
#pragma unroll
    for (int d8 = 0; d8 < 64; d8 += 8) {
#pragma unroll
        for (int j = 0; j < 8; ++j) __builtin_nontemporal_store(S[d8 + j], op + j * 128);
        op += 1024; asm volatile("" ::: "memory"); }
#pragma unroll
    for (int t = 0; t < 4; ++t) po[((sub * 2 + hf) * 4 + t) * 128 + e] = ot[t];
    __syncthreads();
#pragma unroll
    for (int t = 0; t < 4; ++t) { ot[t] = po[((sub * 2) * 4 + t) * 128 + e] + po[((sub * 2 + 1) * 4 + t) * 128 + e]; const float p = wave_sum(ot[t] * ot[t]); if (lane == 0 && hf == 0) red[(sub * 4 + t) * 4 + (wid & 1)] = p; }
    __syncthreads();
    if (hf == 0) { const float gg = g_out[h * 128 + e];
#pragma unroll
        for (int t = 0; t < 4; ++t) { const float tot = red[(sub * 4 + t) * 4] + red[(sub * 4 + t) * 4 + 1]; const float rinv = rsqrtf(tot * (1.f / 128.f) + EPSF);
            oproj[((size_t)MP + b * 4 + t) * NPROJ + C_HQ + h * 128 + e] = f2bf(ot[t] * rinv * gg * siluf_(gt[t])); } }
    __syncthreads();
}
__device__ __forceinline__ void gdn_sample(LAS unsigned char* lds, int it, bf16_t* proj, const float* ab, const float* wconv, const float* a_log, const float* dt_bias, const float* cv_in, float* cv_out,
                                           const float* st_in, float* st_out, const float* g_out, bf16_t* oproj) {
    const int tid = otid(), lane = tid & 63, wid = tid >> 6, sub = tid >> 8, hf = (tid >> 7) & 1, e = tid & 127;
    const int bh = it * 2 + sub, b = bh >> 2, h = bh & 3;
    LAS float* qs = (LAS float*)lds; LAS float* ks = qs + 1024; LAS float* red = ks + 1024; LAS float* po = red + 64;
    float x[3][4];
#pragma unroll
    for (int grp = 0; grp < 3; ++grp) { const int ch = grp * 512 + h * 128 + e; float u[7], w[4];
#pragma unroll
        for (int j = 0; j < 3; ++j) u[j] = cv_in[((size_t)b * 3 + j) * 1536 + ch];
#pragma unroll
        for (int t = 0; t < 4; ++t) u[3 + t] = bf2f(proj[((size_t)MP + b * 4 + t) * NPROJ + C_GQKV + ch]);
#pragma unroll
        for (int j = 0; j < 4; ++j) w[j] = wconv[j * 1536 + ch];
#pragma unroll
        for (int t = 0; t < 4; ++t) x[grp][t] = siluf_(w[0] * u[t] + w[1] * u[t + 1] + w[2] * u[t + 2] + w[3] * u[t + 3]);
        if (hf == 0) {
#pragma unroll
            for (int j = 0; j < 3; ++j) cv_out[((size_t)b * 3 + j) * 1536 + ch] = u[4 + j]; } }
#pragma unroll
    for (int t = 0; t < 4; ++t) { const float pq = wave_sum(x[0][t] * x[0][t]), pk = wave_sum(x[1][t] * x[1][t]);
        if (lane == 0 && hf == 0) { red[(sub * 8 + t) * 4 + (wid & 1)] = pq; red[(sub * 8 + 4 + t) * 4 + (wid & 1)] = pk; } }
    __syncthreads();
    float beta[4], av[4], zt[4];
#pragma unroll
    for (int t = 0; t < 4; ++t) { const float sq = red[(sub * 8 + t) * 4] + red[(sub * 8 + t) * 4 + 1], sk = red[(sub * 8 + 4 + t) * 4] + red[(sub * 8 + 4 + t) * 4 + 1];
        if (hf == 0) { qs[(sub * 4 + t) * 128 + e] = x[0][t] * rsqrtf(sq + EPSF) * 0.08838834764831845f; ks[(sub * 4 + t) * 128 + e] = x[1][t] * rsqrtf(sk + EPSF); }
        const size_t row = (size_t)MP + b * 4 + t; beta[t] = sigmoidf_(ab[row * 8 + 4 + h]); av[t] = __expf(-__expf(a_log[h]) * softplusf_(ab[row * 8 + h] + dt_bias[h]));
        zt[t] = bf2f(proj[row * NPROJ + C_GZ + h * 128 + e]); }
    __syncthreads();
    float S[64]; const float* sp = st_in + (size_t)bh * 16384 + (size_t)hf * 8192 + e;
#pragma unroll
    for (int d8 = 0; d8 < 64; d8 += 8) {
#pragma unroll
        for (int j = 0; j < 8; ++j) S[d8 + j] = __builtin_nontemporal_load(sp + j * 128);
        sp += 1024; asm volatile("" ::: "memory"); }
    float ot[4];
#pragma unroll
    for (int t = 0; t < 4; ++t) { const LAS float* kq = ks + (sub * 4 + t) * 128 + hf * 64; const LAS float* qq = qs + (sub * 4 + t) * 128 + hf * 64; float kS = 0.f;
#pragma unroll
        for (int d4 = 0; d4 < 64; d4 += 4) { const f32x4 k4 = *(const LAS f32x4*)(kq + d4);
#pragma unroll
            for (int j = 0; j < 4; ++j) kS += k4[j] * S[d4 + j];
            asm volatile("" : "+v"(kS) :: "memory"); }
        po[((sub * 2 + hf) * 4 + t) * 128 + e] = kS;
        __syncthreads();
        kS = po[((sub * 2) * 4 + t) * 128 + e] + po[((sub * 2 + 1) * 4 + t) * 128 + e];
        const float a = av[t], vn = beta[t] * (x[2][t] - a * kS); float o = 0.f;
#pragma unroll
        for (int d4 = 0; d4 < 64; d4 += 4) { const f32x4 k4 = *(const LAS f32x4*)(kq + d4), q4 = *(const LAS f32x4*)(qq + d4);
#pragma unroll
            for (int j = 0; j < 4; ++j) { S[d4 + j] = a * S[d4 + j] + k4[j] * vn; o += q4[j] * S[d4 + j]; }
            asm volatile("" : "+v"(S[d4]), "+v"(S[d4 + 1]), "+v"(S[d4 + 2]), "+v"(S[d4 + 3]), "+v"(o) :: "memory"); }
        ot[t] = o; }
    float* op = st_out + (size_t)bh * 16384 + (size_t)hf * 8192 + e;
#pragma unroll
    for (int d8 = 0; d8 < 64; d8 += 8) {
#pragma unroll
        for (int j = 0; j < 8; ++j) __builtin_nontemporal_store(S[d8 + j], op + j * 128);
        op += 1024; asm volatile("" ::: "memory"); }
    __syncthreads();
#pragma unroll
    for (int t = 0; t < 4; ++t) po[((sub * 2 + hf) * 4 + t) * 128 + e] = ot[t];
    __syncthreads();
#pragma unroll
    for (int t = 0; t < 4; ++t) { ot[t] = po[((sub * 2) * 4 + t) * 128 + e] + po[((sub * 2 + 1) * 4 + t) * 128 + e]; const float p = wave_sum(ot[t] * ot[t]); if (lane == 0 && hf == 0) red[(sub * 8 + t) * 4 + (wid & 1)] = p; }
    __syncthreads();
    if (hf == 0) { const float gg = g_out[e];
#pragma unroll
        for (int t = 0; t < 4; ++t) { const float tot = red[(sub * 8 + t) * 4] + red[(sub * 8 + t) * 4 + 1]; const float rinv = rsqrtf(tot * (1.f / 128.f) + EPSF);
            oproj[((size_t)MP + b * 4 + t) * NPROJ + C_GQKV + h * 128 + e] = f2bf(ot[t] * rinv * gg * siluf_(zt[t])); } }
    __syncthreads();
}

template <bool SAMPLE>
__device__ __forceinline__ void attn_item(LAS unsigned char* lds, int idx, bf16_t* proj, const bf16_t* mk, const bf16_t* mv, const float* ck, const float* cv) {
    const int tid = otid(), lane = tid & 63, wid = tid >> 6, r = lane & 15, q = lane >> 4;
    LAS bf16_t* Ks = (LAS bf16_t*)lds;
    LAS bf16_t* VT = Ks + 256 * 136;
    int b, h, qc = 0;
    if (SAMPLE) { b = idx >> 2; h = idx & 3; } else { b = idx >> 6; h = (idx >> 4) & 3; qc = idx & 15; }
#pragma unroll
    for (int i = 0; i < 8; ++i) { const int ch = tid + i * 512, key = ch >> 4, dg = ch & 15; u32x4 kv, vv;
        if (SAMPLE) { const float* pk_ = ck + (((size_t)b * 256 + key) * 4 + h) * 128 + dg * 8; const float* pv_ = cv + (((size_t)b * 256 + key) * 4 + h) * 128 + dg * 8;
            const f32x4 k0 = __builtin_nontemporal_load((const f32x4*)pk_), k1 = __builtin_nontemporal_load((const f32x4*)(pk_ + 4)), v0 = __builtin_nontemporal_load((const f32x4*)pv_), v1 = __builtin_nontemporal_load((const f32x4*)(pv_ + 4));
            kv.x = pk2(k0[0], k0[1]); kv.y = pk2(k0[2], k0[3]); kv.z = pk2(k1[0], k1[1]); kv.w = pk2(k1[2], k1[3]);
            vv.x = pk2(v0[0], v0[1]); vv.y = pk2(v0[2], v0[3]); vv.z = pk2(v1[0], v1[1]); vv.w = pk2(v1[2], v1[3]); }
        else { kv = *(const u32x4*)(mk + ((size_t)b * 256 + key) * 512 + h * 128 + dg * 8); vv = *(const u32x4*)(mv + ((size_t)b * 256 + key) * 512 + h * 128 + dg * 8); }
        *(LAS u32x4*)(Ks + key * 136 + dg * 8) = kv;
        LAS bf16_t* vt = VT + (dg * 8) * 264 + key;
        vt[0] = (bf16_t)(vv.x & 0xffff); vt[264] = (bf16_t)(vv.x >> 16); vt[2 * 264] = (bf16_t)(vv.y & 0xffff); vt[3 * 264] = (bf16_t)(vv.y >> 16);
        vt[4 * 264] = (bf16_t)(vv.z & 0xffff); vt[5 * 264] = (bf16_t)(vv.z >> 16); vt[6 * 264] = (bf16_t)(vv.w & 0xffff); vt[7 * 264] = (bf16_t)(vv.w >> 16); }
    __syncthreads();
    if (!SAMPLE || wid == 0) {
        LAS bf16_t* Ksl = Ks; LAS bf16_t* VTl = VT;
        const size_t row0 = SAMPLE ? ((size_t)MP + b * 4) : ((size_t)b * TSEQ + qc * 128 + wid * 16);
        const int tq = SAMPLE ? (r & 3) : r;
        bf16_t* qrow = proj + (row0 + tq) * NPROJ + C_MQ + h * 128;
        bf16x8 Yq[4];
#pragma unroll
        for (int ks = 0; ks < 4; ++ks) Yq[ks] = *(const bf16x8*)(qrow + ks * 32 + q * 8);
        f32x4 sacc[16];
#pragma unroll
        for (int kt = 0; kt < 16; ++kt) { sacc[kt] = (f32x4){0.f, 0.f, 0.f, 0.f};
#pragma unroll
            for (int ks = 0; ks < 4; ++ks) { const bf16x8 X = *(const LAS bf16x8*)(Ksl + (16 * kt + r) * 136 + ks * 32 + q * 8); sacc[kt] = mfma16(X, Yq[ks], sacc[kt]); } __builtin_amdgcn_sched_barrier(0); }
        float m = -1e30f;
#pragma unroll
        for (int kt = 0; kt < 16; ++kt) m = fmaxf(m, fmaxf(fmaxf(sacc[kt][0], sacc[kt][1]), fmaxf(sacc[kt][2], sacc[kt][3])));
        m = fmaxf(m, __shfl_xor(m, 16)); m = fmaxf(m, __shfl_xor(m, 32));
        float sum = 0.f;
#pragma unroll
        for (int kt = 0; kt < 16; ++kt)
#pragma unroll
            for (int jj = 0; jj < 4; ++jj) { const float p = __expf((sacc[kt][jj] - m) * 0.08838834764831845f); sacc[kt][jj] = p; sum += p; }
        sum += __shfl_xor(sum, 16); sum += __shfl_xor(sum, 32);
        f32x4 oacc[8];
#pragma unroll
        for (int et = 0; et < 8; ++et) oacc[et] = (f32x4){0.f, 0.f, 0.f, 0.f};
#pragma unroll
        for (int k8 = 0; k8 < 8; ++k8) { const bf16x8 Pf = pkfrag(sacc[2 * k8], sacc[2 * k8 + 1]);
#pragma unroll
            for (int et = 0; et < 8; ++et) { const LAS bf16_t* pp = VTl + (16 * et + r) * 264 + 32 * k8 + 4 * q; oacc[et] = mfma16(ld2x4(pp, pp + 16), Pf, oacc[et]); } __builtin_amdgcn_sched_barrier(0); }
        const float inv = 1.0f / sum;
        if (!SAMPLE || r < 4) { bf16_t* orow = proj + (row0 + r) * NPROJ + C_MQ + h * 128;
#pragma unroll
            for (int et = 0; et < 8; ++et) { u32x2 w; w.x = pk2(oacc[et][0] * inv, oacc[et][1] * inv); w.y = pk2(oacc[et][2] * inv, oacc[et][3] * inv); *(u32x2*)(orow + 16 * et + 4 * q) = w; } }
    }
    __syncthreads();
}

__device__ __forceinline__ void phase2(LAS unsigned char* lds) {
    const int nb = gridDim.x;
    { KA ap = kargs(); const int bid = obid(); unsigned char* ws = ap->ws; unsigned char* ob = (unsigned char*)ap->out; float* out = ap->out; bf16_t* proj = (bf16_t*)(ws + WS_PROJ);
      for (int item = bid; item < 1024; item += nb)
        gdn_passA(lds, item, proj, (const float*)(ws + WS_AB), ap->in[11], ap->in[12], ap->in[13], (bf16_t*)(ob + OB_UT), (bf16_t*)(ob + OB_W), (bf16_t*)(ws + WS_KGT), (bf16_t*)(ws + WS_QG), (bf16_t*)(ws + WS_AQK),
                  (float*)(ws + WS_GCS), out + O_CVP); }
    { KA ap = kargs(); const int bid = obid(); unsigned char* ws = ap->ws; unsigned char* ob = (unsigned char*)ap->out; bf16_t* proj = (bf16_t*)(ws + WS_PROJ);
      for (int item = bid; item < 1024; item += nb) hg_pass1(lds, item, proj, ap->in[8], (bf16_t*)(ob + OB_DS), (float*)(ws + WS_DEC)); }
}
__device__ __forceinline__ void phase3(LAS unsigned char* lds) {
    KA ap = kargs(); const int bid = obid(), nb = gridDim.x;
    unsigned char* ws = ap->ws; unsigned char* ob = (unsigned char*)ap->out; float* out = ap->out;
    if (bid < 32) {
        gdn_passB(lds, bid, (bf16_t*)(ob + OB_UT), (bf16_t*)(ob + OB_W), (bf16_t*)(ws + WS_KGT), (const float*)(ws + WS_GCS), out + O_GDP);
    } else {
        const int tid = otid();
        { const int per = (65536 + (nb - 32) - 1) / (nb - 32); if (tid < per) { const int task = (bid - 32) * per + tid; if (task < 65536) hg_pass2(task, (bf16_t*)(ob + OB_DS), (const float*)(ws + WS_DEC), out + O_HGP); } }
        bf16_t* proj = (bf16_t*)(ws + WS_PROJ);
        for (int e = bid - 32; e < 1536; e += nb - 32) {
            if (e < 256) hg_sample(lds, e, proj, ap->in[8], ap->in[5], out + O_HGS, ap->in[14], proj);
            else if (e < 512) gdn_sample(lds, e - 256, proj, (const float*)(ws + WS_AB), ap->in[11], ap->in[12], ap->in[13], ap->in[7], out + O_CVS, ap->in[6], out + O_GDS, ap->in[15], proj);
            else if (e < 1024) attn_item<true>(lds, e - 512, proj, nullptr, nullptr, ap->in[3], ap->in[4]);
            else attn_item<false>(lds, e - 1024, proj, (const bf16_t*)(ws + WS_MEMK), (const bf16_t*)(ws + WS_MEMV), nullptr, nullptr);
        }
    }
}
template <int BR> struct EpiMerge {
    static constexpr bool PERM = false;
    float* macc; bf16_t* merged; const bf16_t* proj; bf16_t* merged_s;
    __device__ __forceinline__ void operator()(const f32x4 (&acc)[2][2][4][2], const Unit& u, int wr, int wc, int fr, int fq) const {
        const int row0 = u.pm * 256 + wr * 64 + fr, col0 = u.pn * 256 + wc * 32 + 4 * fq;
#pragma unroll
        for (int ai = 0; ai < 2; ++ai)
#pragma unroll
            for (int m = 0; m < 4; ++m) { const size_t row = (size_t)(row0 + ai * 128 + m * 16);
#pragma unroll
                for (int bj = 0; bj < 2; ++bj)
#pragma unroll
                    for (int n = 0; n < 2; ++n) { const int col = col0 + bj * 128 + n * 16; const u32x2 gz = *(const u32x2*)(proj + row * NPROJ + C_GATE + BR * 1024 + col);
                        f32x4 v; v[0] = sigmoidf_(__uint_as_float(gz.x << 16)) * acc[ai][bj][m][n][0]; v[1] = sigmoidf_(__uint_as_float(gz.x & 0xffff0000u)) * acc[ai][bj][m][n][1];
                        v[2] = sigmoidf_(__uint_as_float(gz.y << 16)) * acc[ai][bj][m][n][2]; v[3] = sigmoidf_(__uint_as_float(gz.y & 0xffff0000u)) * acc[ai][bj][m][n][3];
                        if (BR > 0) v += *(const f32x4*)(macc + row * DM + col);
                        if (BR < 2) *(f32x4*)(macc + row * DM + col) = v;
                        else { u32x2 w; w.x = pg8::cvt_pk_bf16(v[0], v[1]); w.y = pg8::cvt_pk_bf16(v[2], v[3]); *(u32x2*)((row >= MP ? merged_s - (size_t)MP * DM : merged) + row * DM + col) = w; } } }
    }
};
struct EpiOutF32 {
    static constexpr bool PERM = false;
    float* O; float* part;
    __device__ __forceinline__ void operator()(const f32x4 (&acc)[2][2][4][2], const Unit& u, int wr, int wc, int fr, int fq) const {
        const int row0 = u.pm * 256 + wr * 64 + fr, col0 = u.pn * 256 + wc * 32 + 4 * fq;
        float* base = u.tag ? part + ((size_t)(u.tag - 1) * MS - MP) * DM : O;
#pragma unroll
        for (int ai = 0; ai < 2; ++ai)
#pragma unroll
            for (int m = 0; m < 4; ++m) { const size_t row = (size_t)(row0 + ai * 128 + m * 16);
#pragma unroll
                for (int bj = 0; bj < 2; ++bj)
#pragma unroll
                    for (int n = 0; n < 2; ++n) *(f32x4*)(base + row * DM + col0 + bj * 128 + n * 16) = acc[ai][bj][m][n]; }
    }
};
struct EpiSwiGLU {
    static constexpr bool PERM = true;
    bf16_t* O; const float* rs;
    __device__ __forceinline__ void operator()(const f32x4 (&acc)[2][2][4][2], const Unit& u, int wr, int wc, int fr, int fq) const {
        const int row0 = u.pm * 256 + wr * 64 + fr, col0 = u.pn * 128 + wc * 32 + 8 * fq;
#pragma unroll
        for (int ai = 0; ai < 2; ++ai)
#pragma unroll
            for (int m = 0; m < 4; ++m) { const size_t row = (size_t)(row0 + ai * 128 + m * 16); const float r = rs[row]; float o[8];
#pragma unroll
                for (int n = 0; n < 2; ++n)
#pragma unroll
                    for (int j = 0; j < 4; ++j) { const float g = acc[ai][0][m][n][j] * r, up = acc[ai][1][m][n][j] * r; o[n * 4 + j] = siluf_(g) * up; }
                u32x4 w; w.x = pg8::cvt_pk_bf16(o[0], o[1]); w.y = pg8::cvt_pk_bf16(o[2], o[3]); w.z = pg8::cvt_pk_bf16(o[4], o[5]); w.w = pg8::cvt_pk_bf16(o[6], o[7]);
                *(u32x4*)(O + row * FFH + col0) = w; }
    }
};

template <class Sched>
__device__ __forceinline__ void merged_gemms(LAS unsigned char* lds, const Sched& S) {
    KA ap = kargs(); unsigned char* ws = ap->ws; float* macc = ap->out; const bf16_t* proj = (const bf16_t*)(ws + WS_PROJ); bf16_t* merged = (bf16_t*)(ws + WS_MERGED); bf16_t* ms = (bf16_t*)(ws + WS_MRGS);
    { pg8::Gemm g{proj + C_HQ, (const bf16_t*)(ws + WS_WBR), MT, DM, 512, NPROJ, nullptr}; EpiMerge<0> E{macc, merged, proj, ms}; pg8::gemm_phase(lds, g, S, E); }
    { pg8::Gemm g{proj + C_GQKV, (const bf16_t*)(ws + WS_WBR) + (size_t)DM * 512, MT, DM, 512, NPROJ, nullptr}; EpiMerge<1> E{macc, merged, proj, ms}; pg8::gemm_phase(lds, g, S, E); }
    { pg8::Gemm g{proj + C_MQ, (const bf16_t*)(ws + WS_WBR) + (size_t)2 * DM * 512, MT, DM, 512, NPROJ, nullptr}; EpiMerge<2> E{macc, merged, proj, ms}; pg8::gemm_phase(lds, g, S, E); }
}
__device__ __forceinline__ void phase5(LAS unsigned char* lds) {
    pg8::StaticOrder S; S.init(MP, DM, gridDim.x, obid(), 512); merged_gemms(lds, S);
}
__device__ __forceinline__ void phase4(LAS unsigned char* lds) {
    if (obid() < 8) { pg8::SampleOrder S; S.init(512, 8, obid()); merged_gemms(lds, S); return; }
    KA ap = kargs(); const int bid = obid() - 8, nb = gridDim.x - 8;
    unsigned char* ws = ap->ws; unsigned char* ob = (unsigned char*)ap->out;
#if PROBE_DRY & 4
    for (int item = bid; item < 1024; item += nb) gdn_passC(lds, item, (bf16_t*)(ws + WS_PROJ), (const bf16_t*)(ob + OB_UT), (const bf16_t*)(ob + OB_W), (const bf16_t*)(ws + WS_KGT), (const bf16_t*)(ws + WS_QG), (const bf16_t*)(ws + WS_AQK), ap->in[15], C_GQKV + 1024);
#endif
#if PROBE_DRY & 8
    for (int item = bid; item < 1024; item += nb) hg_pass3(lds, item, (bf16_t*)(ws + WS_PROJ), ap->in[8], (const bf16_t*)(ob + OB_DS), ap->in[14], C_GQKV + 512);
#endif
    for (int item = bid; item < 1024; item += nb) gdn_passC(lds, item, (bf16_t*)(ws + WS_PROJ), (const bf16_t*)(ob + OB_UT), (const bf16_t*)(ob + OB_W), (const bf16_t*)(ws + WS_KGT), (const bf16_t*)(ws + WS_QG), (const bf16_t*)(ws + WS_AQK), ap->in[15]);
    for (int item = bid; item < 1024; item += nb) hg_pass3(lds, item, (bf16_t*)(ws + WS_PROJ), ap->in[8], (const bf16_t*)(ob + OB_DS), ap->in[14]);
}

__device__ __forceinline__ void phase6(LAS unsigned char* lds) {
    KA ap = kargs(); unsigned char* ws = ap->ws;
    pg8::Gemm g{(const bf16_t*)(ws + WS_MERGED), (const bf16_t*)(ws + WS_WOUT), MT, DM, DM, DM, (const bf16_t*)(ws + WS_MRGS) - (size_t)MP * DM};
    pg8::TailOrder S; S.init(DM, DM, gridDim.x, obid(), 4); EpiOutF32 E{ap->out, (float*)(ws + WS_PART)}; pg8::gemm_phase(lds, g, S, E);
    { const int bid = obid(), nb = gridDim.x;
      if (bid >= 32) { __syncthreads(); xpose_convert((LAS float*)lds, ap->in[24], 2 * FFH, DM, 2 * FFH, (bf16_t*)(ws + WS_WF1), ap->in[23], 2, bid - 32, nb - 32); } }
}
__device__ __forceinline__ void phase7(LAS unsigned char* lds) {
    KA ap = kargs(); unsigned char* ws = ap->ws; const int bid = obid(), nb = gridDim.x;
    const int tid = otid(), lane = tid & 63, wid = tid >> 6;
    const float* part = (const float*)(ws + WS_PART); const float* gpm = ap->in[22]; float* hbuf = ap->out; bf16_t* hb = (bf16_t*)(ws + WS_HB); float* rh = (float*)(ws + WS_RH);
    const float* x0 = ap->in[0]; const float* x1 = ap->in[1];
    f32x4 gv[4];
#pragma unroll
    for (int i = 0; i < 4; ++i) gv[i] = *(const f32x4*)(gpm + i * 256 + lane * 4);
    const int stride = nb * 8;
    for (int rowb = bid * 8 + wid; rowb < MT; rowb += 2 * stride) {
        f32x4 mv[2][4], xv[2][4]; float sm[2];
#pragma unroll
        for (int u = 0; u < 2; ++u) { const int row = rowb + u * stride; sm[u] = 0.f;
            if (row < MT) { const float* xr = row < MP ? x0 + (size_t)row * DM : x1 + (size_t)(row - MP) * DM;
#pragma unroll
                for (int i = 0; i < 4; ++i) { const int k = i * 256 + lane * 4; xv[u][i] = __builtin_nontemporal_load((const f32x4*)(xr + k));
                    if (row < MP) mv[u][i] = __builtin_nontemporal_load((const f32x4*)(hbuf + (size_t)row * DM + k));
                    else { mv[u][i] = *(const f32x4*)(part + (size_t)(row - MP) * DM + k);
#pragma unroll
                        for (int sp = 1; sp < 4; ++sp) mv[u][i] += *(const f32x4*)(part + ((size_t)sp * MS + (row - MP)) * DM + k); } } } }
#pragma unroll
        for (int u = 0; u < 2; ++u) { const int row = rowb + u * stride;
            if (row < MT) {
#pragma unroll
                for (int i = 0; i < 4; ++i) sm[u] += mv[u][i][0] * mv[u][i][0] + mv[u][i][1] * mv[u][i][1] + mv[u][i][2] * mv[u][i][2] + mv[u][i][3] * mv[u][i][3];
                const float r = rsqrtf(wave_sum(sm[u]) * (1.f / DM) + EPSF); float ss = 0.f;
#pragma unroll
                for (int i = 0; i < 4; ++i) { const int k = i * 256 + lane * 4;
                    const f32x4 hv = xv[u][i] + mv[u][i] * gv[i] * r; ss += hv[0] * hv[0] + hv[1] * hv[1] + hv[2] * hv[2] + hv[3] * hv[3];
                    __builtin_nontemporal_store(hv, (f32x4*)(hbuf + (size_t)row * DM + k)); u32x2 w; w.x = pk2(hv[0], hv[1]); w.y = pk2(hv[2], hv[3]); *(u32x2*)(hb + (size_t)row * DM + k) = w; }
                ss = wave_sum(ss); if (lane == 0) rh[row] = rsqrtf(ss * (1.f / DM) + EPSF); } }
    }
}
__device__ __forceinline__ void phase8(LAS unsigned char* lds) {
    KA ap = kargs(); unsigned char* ws = ap->ws;
    pg8::Gemm g{(const bf16_t*)(ws + WS_HB), (const bf16_t*)(ws + WS_WF1), MT, 2 * FFH, DM, DM, nullptr}; pg8::StaticOrder S; S.init(MT, 2 * FFH, gridDim.x, obid()); EpiSwiGLU E{(bf16_t*)(ws + WS_ACT), (const float*)(ws + WS_RH)}; pg8::gemm_phase(lds, g, S, E);
    { const int nb = gridDim.x, nun = (MT / 256) * (2 * FFH / 256), rem = nun % nb, bid = obid();
      if (rem > 0 && bid >= rem) { __syncthreads(); xpose_convert((LAS float*)lds, ap->in[25], DM, FFH, DM, (bf16_t*)(ws + WS_WF2), nullptr, 0, bid - rem, nb - rem); }
      else if (rem == 0) { __syncthreads(); xpose_convert((LAS float*)lds, ap->in[25], DM, FFH, DM, (bf16_t*)(ws + WS_WF2), nullptr, 0, bid, nb); } }
}
__device__ __forceinline__ void phase9(LAS unsigned char* lds) {
    KA ap = kargs(); unsigned char* ws = ap->ws;
    pg8::Gemm g{(const bf16_t*)(ws + WS_ACT), (const bf16_t*)(ws + WS_WF2), MT, DM, FFH, FFH, (const bf16_t*)(ws + WS_ACT)};
    pg8::TailOrder S; S.init(DM, FFH, gridDim.x, obid(), 11); EpiOutF32 E{(float*)(ws + WS_FF), (float*)(ws + WS_PART)}; pg8::gemm_phase(lds, g, S, E);
}
__device__ __forceinline__ void phase10(LAS unsigned char* lds) {
    KA ap = kargs(); unsigned char* ws = ap->ws; const int bid = obid(), nb = gridDim.x;
    const int tid = otid(), lane = tid & 63, wid = tid >> 6;
    const float* part = (const float*)(ws + WS_PART); const float* gpf = ap->in[26]; float* hbuf = ap->out; const float* ff = (const float*)(ws + WS_FF);
    f32x4 gv[4];
#pragma unroll
    for (int i = 0; i < 4; ++i) gv[i] = *(const f32x4*)(gpf + i * 256 + lane * 4);
    const int stride = nb * 8;
    for (int rowb = bid * 8 + wid; rowb < MT; rowb += 2 * stride) {
        f32x4 fv[2][4], hv[2][4];
#pragma unroll
        for (int u = 0; u < 2; ++u) { const int row = rowb + u * stride;
            if (row < MT) {
#pragma unroll
                for (int i = 0; i < 4; ++i) { const int k = i * 256 + lane * 4; hv[u][i] = __builtin_nontemporal_load((const f32x4*)(hbuf + (size_t)row * DM + k));
                    if (row < MP) fv[u][i] = __builtin_nontemporal_load((const f32x4*)(ff + (size_t)row * DM + k));
                    else { fv[u][i] = *(const f32x4*)(part + (size_t)(row - MP) * DM + k);
#pragma unroll
                        for (int sp = 1; sp < 11; ++sp) fv[u][i] += *(const f32x4*)(part + ((size_t)sp * MS + (row - MP)) * DM + k); } } } }
#pragma unroll
        for (int u = 0; u < 2; ++u) { const int row = rowb + u * stride;
            if (row < MT) { float sm = 0.f;
#pragma unroll
                for (int i = 0; i < 4; ++i) sm += fv[u][i][0] * fv[u][i][0] + fv[u][i][1] * fv[u][i][1] + fv[u][i][2] * fv[u][i][2] + fv[u][i][3] * fv[u][i][3];
                const float r = rsqrtf(wave_sum(sm) * (1.f / DM) + EPSF);
#pragma unroll
                for (int i = 0; i < 4; ++i) { const int k = i * 256 + lane * 4; __builtin_nontemporal_store(hv[u][i] + fv[u][i] * gv[i] * r, (f32x4*)(hbuf + (size_t)row * DM + k)); } } }
    }
}

__global__ void __launch_bounds__(512) fwd_kernel(Args a) {
    extern __shared__ __attribute__((aligned(16))) unsigned char smem_raw[];
    LAS unsigned char* lds = (LAS unsigned char*)smem_raw;
    cg::grid_group grid = cg::this_grid();
    const int ph_lo = kargs()->ph_lo, ph_hi = kargs()->ph_hi;
    volatile LAS unsigned* bst = (volatile LAS unsigned*)(lds + LDS_BYTES - 16);
    if (threadIdx.x == 0) { bst[0] = 0u; bst[1] = 0u; }
    __syncthreads();
    const XcdBarrier xb = xcd_barrier_post((unsigned*)(kargs()->ws + WS_BAR), bst);
    if (ph_hi > 1000) grid.sync();
#define PHASE(k, call) if (ph_lo <= (k) && (k) < ph_hi) { if ((k) > ph_lo) xcd_barrier(xb); call; __syncthreads(); if (PROBE_MASK & (1 << (k))) { call; __syncthreads(); } }
    PHASE(0, phase0(lds))
    PHASE(1, phase1(lds))
    PHASE(2, phase2(lds))
    PHASE(3, phase3(lds))
    PHASE(4, phase4(lds))
    PHASE(5, phase5(lds))
    PHASE(6, phase6(lds))
    PHASE(7, phase7(lds))
    PHASE(8, phase8(lds))
    PHASE(9, phase9(lds))
    PHASE(10, phase10(lds))
#undef PHASE
}

extern "C" void kernel_launch(void* const* d_in, const int* in_sizes, int n_in, void* d_out, int out_size, void* d_ws, size_t ws_size, hipStream_t stream) {
    static int grid = 0;
    if (grid == 0) {
        int dev = 0, cus = 0, per_cu = 0;
        hipGetDevice(&dev);
        hipDeviceGetAttribute(&cus, hipDeviceAttributeMultiprocessorCount, dev);
        if (hipFuncSetAttribute((const void*)fwd_kernel, hipFuncAttributeMaxDynamicSharedMemorySize, LDS_BYTES) != hipSuccess) fprintf(stderr, "hipFuncSetAttribute failed\n");
        hipOccupancyMaxActiveBlocksPerMultiprocessor(&per_cu, (const void*)fwd_kernel, 512, LDS_BYTES);
        if (per_cu < 1) { fprintf(stderr, "occupancy query says %d\n", per_cu); per_cu = 1; }
        grid = cus * 1;
        if (ws_size < WS_END) fprintf(stderr, "workspace too small: %zu < %zu\n", ws_size, (size_t)WS_END);
        if (grid < 64) fprintf(stderr, "grid too small: %d\n", grid);
    }
    hipMemsetAsync((unsigned char*)d_ws + WS_BAR, 0, 16384, stream);
    Args a{};
    for (int i = 0; i < 27; ++i) a.in[i] = (const float*)d_in[i];
    a.out = (float*)d_out; a.ws = (unsigned char*)d_ws; a.ph_lo = 0; a.ph_hi = 12;
    void* args[] = {&a};
    hipError_t e = hipLaunchCooperativeKernel((const void*)fwd_kernel, dim3(grid), dim3(512), args, LDS_BYTES, stream);
    if (e != hipSuccess) fprintf(stderr, "cooperative launch failed: %s (grid %d)\n", hipGetErrorString(e), grid);
}
```
